# Optimizing an MI355X kernel written in HIP

```python
import math
import jax, jax.numpy as jnp
from jax import lax
import numpy as np

D_MODEL = 2048
BATCH = 2
SEQ = 16384
DEPTH = 2

CHUNK = 64
LEFT_CHUNKS = 8
BAND = (LEFT_CHUNKS + 1) * CHUNK
A_HEADS = 32
A_HEAD_DIM = D_MODEL // A_HEADS
REL_CLIP = 2 * CHUNK
B_HEADS = 16
B_HEAD_DIM = D_MODEL // B_HEADS
Q_BLOCK = 128
N_A_LAYERS = DEPTH // 2
N_EXPERTS = 16
N_GROUPS = 4
EXPERTS_PER_GROUP = N_EXPERTS // N_GROUPS
TOP_K = 2
D_FF = 2048
EXPERT_BLOCK = 256
ALPHA = (2.0 * DEPTH) ** 0.25
BETA = (8.0 * DEPTH) ** -0.25
LN_EPS = 1e-5
NEG = -1e30

kernel_name = "yoco_chunk_relpos_fox_grouped_moe_deepnorm"


def layer_norm(x, gain, bias):
    xf = x.astype(jnp.float32)
    mu = jnp.mean(xf, axis=-1, keepdims=True)
    var = jnp.mean(jnp.square(xf - mu), axis=-1, keepdims=True)
    y = (xf - mu) * lax.rsqrt(var + LN_EPS) * gain.astype(jnp.float32) + bias.astype(jnp.float32)
    return y.astype(x.dtype)


def chunk_relpos_attention(x, w_qkv, rel_bias, w_o):
    b, s, d = x.shape
    nc = s // CHUNK
    pad = LEFT_CHUNKS * CHUNK
    q, k, v = jnp.split(x @ w_qkv, 3, axis=-1)
    q = q.reshape(b, nc, CHUNK, A_HEADS, A_HEAD_DIM).transpose(1, 0, 2, 3, 4)
    k = jnp.pad(k.reshape(b, s, A_HEADS, A_HEAD_DIM), ((0, 0), (pad, 0), (0, 0), (0, 0)))
    v = jnp.pad(v.reshape(b, s, A_HEADS, A_HEAD_DIM), ((0, 0), (pad, 0), (0, 0), (0, 0)))
    rel = jnp.arange(CHUNK)[:, None] - jnp.arange(BAND)[None, :] + pad
    bias = rel_bias[:, jnp.clip(rel, -REL_CLIP, REL_CLIP) + REL_CLIP].astype(jnp.float32)
    scale = 1.0 / math.sqrt(A_HEAD_DIM)

    def one_chunk(args):
        qc, c = args
        kc = lax.dynamic_slice_in_dim(k, c * CHUNK, BAND, axis=1)
        vc = lax.dynamic_slice_in_dim(v, c * CHUNK, BAND, axis=1)
        sc = jnp.einsum('bqhd,bkhd->bhqk', qc, kc).astype(jnp.float32) * scale + bias[None]
        key_pos = c * CHUNK - pad + jnp.arange(BAND)
        sc = jnp.where((key_pos >= 0)[None, None, None, :], sc, NEG)
        p = jax.nn.softmax(sc, axis=-1)
        return jnp.einsum('bhqk,bkhd->bqhd', p.astype(vc.dtype), vc)

    out = lax.map(one_chunk, (q, jnp.arange(nc)))
    out = out.transpose(1, 0, 2, 3, 4).reshape(b, s, d)
    return out @ w_o


def shared_kv_side(x, kv_w, fg_w, fg_b):
    b, s, d = x.shape
    k, v = jnp.split(x @ kv_w, 2, axis=-1)
    k = k.reshape(b, s, B_HEADS, B_HEAD_DIM)
    v = v.reshape(b, s, B_HEADS, B_HEAD_DIM)
    log_f = jax.nn.log_sigmoid((x @ fg_w).astype(jnp.float32) + fg_b.astype(jnp.float32))
    f_cum = jnp.cumsum(log_f, axis=1)
    return k, v, f_cum


def forgetting_attention(x, w_q, w_o, k, v, f_cum):
    b, s, d = x.shape
    nq = s // Q_BLOCK
    q = (x @ w_q).reshape(b, nq, Q_BLOCK, B_HEADS, B_HEAD_DIM).transpose(1, 0, 2, 3, 4)
    fq = f_cum.reshape(b, nq, Q_BLOCK, B_HEADS).transpose(1, 0, 3, 2)
    fk = f_cum.transpose(0, 2, 1)
    key_pos = jnp.arange(s)
    scale = 1.0 / math.sqrt(B_HEAD_DIM)

    def one_block(args):
        qb, fqb, i = args
        sc = jnp.einsum('bqhd,bkhd->bhqk', qb, k).astype(jnp.float32) * scale
        sc = sc + fqb[..., None] - fk[:, :, None, :]
        q_pos = i * Q_BLOCK + jnp.arange(Q_BLOCK)
        sc = jnp.where((key_pos[None, :] <= q_pos[:, None])[None, None], sc, NEG)
        p = jax.nn.softmax(sc, axis=-1)
        return jnp.einsum('bhqk,bkhd->bqhd', p.astype(v.dtype), v)

    out = lax.map(one_block, (q, fq, jnp.arange(nq)))
    out = out.transpose(1, 0, 2, 3, 4).reshape(b, s, d)
    return out @ w_o


def grouped_top2_route(xt, router_w, router_b):
    logits = (xt @ router_w).astype(jnp.float32) + router_b.astype(jnp.float32)
    probs = jax.nn.softmax(logits, axis=-1)
    pg = probs.reshape(-1, N_GROUPS, EXPERTS_PER_GROUP)
    group_score = jnp.sum(lax.top_k(pg, TOP_K)[0], axis=-1)
    g = jnp.argmax(group_score, axis=-1)
    p_in = jnp.take_along_axis(pg, g[:, None, None], axis=1)[:, 0]
    vals, loc = lax.top_k(p_in, TOP_K)
    experts = (g[:, None] * EXPERTS_PER_GROUP + loc).astype(jnp.int32)
    gates = vals / jnp.sum(vals, axis=-1, keepdims=True)
    return experts, gates


def moe_ffn(xt, experts, gates, w_gate, w_up, w_down):
    n, d = xt.shape
    a = n * TOP_K
    e_flat = experts.reshape(-1)
    tok_flat = jnp.repeat(jnp.arange(n, dtype=jnp.int32), TOP_K)
    g_flat = gates.reshape(-1)
    counts = jnp.bincount(e_flat, length=N_EXPERTS)
    starts = jnp.cumsum(counts) - counts
    padded = (counts + EXPERT_BLOCK - 1) // EXPERT_BLOCK * EXPERT_BLOCK
    pend = jnp.cumsum(padded)
    pstart = pend - padded
    order = jnp.argsort(e_flat)
    e_sorted = e_flat[order]
    dest = pstart[e_sorted] + jnp.arange(a) - starts[e_sorted]
    n_blocks = -(-a // EXPERT_BLOCK) + N_EXPERTS
    p = n_blocks * EXPERT_BLOCK
    slot_tok = jnp.full((p,), n, jnp.int32).at[dest].set(tok_flat[order])
    slot_gate = jnp.zeros((p,), jnp.float32).at[dest].set(g_flat[order])
    block_expert = jnp.minimum(
        jnp.searchsorted(pend, jnp.arange(n_blocks) * EXPERT_BLOCK, side='right'), N_EXPERTS - 1)
    x_pad = jnp.concatenate([xt, jnp.zeros((1, d), xt.dtype)], axis=0)
    xb = x_pad[slot_tok].reshape(n_blocks, EXPERT_BLOCK, d)

    def run_block(args):
        xblk, e = args
        hid = jax.nn.silu(xblk @ w_gate[e]) * (xblk @ w_up[e])
        return hid @ w_down[e]

    yb = lax.map(run_block, (xb, block_expert)).reshape(p, d)
    y = jnp.zeros((n + 1, d), yb.dtype).at[slot_tok].add(yb * slot_gate[:, None].astype(yb.dtype))
    return y[:n]


def setup_inputs(seed: int = 0) -> dict:
    key = jax.random.key(seed)
    ks = jax.random.split(key, 20)
    n_a = N_A_LAYERS
    n_b = DEPTH - N_A_LAYERS
    d = D_MODEL
    s = d ** -0.5
    nrm = jax.random.normal
    x = nrm(ks[0], (BATCH, SEQ, d), jnp.float32)
    a_w_qkv = jnp.concatenate([nrm(ks[1], (n_a, d, 2 * d)) * s,
                               nrm(ks[2], (n_a, d, d)) * (s * BETA)], axis=-1)
    a_rel_bias = 0.2 * nrm(ks[3], (n_a, A_HEADS, 2 * REL_CLIP + 1))
    a_w_o = nrm(ks[4], (n_a, d, d)) * (s * BETA)
    kv_w = jnp.concatenate([nrm(ks[5], (d, d)) * s, nrm(ks[6], (d, d)) * (s * BETA)], axis=-1)
    fg_w = nrm(ks[7], (d, B_HEADS)) * s
    fg_b = 2.0 + 2.0 * jax.random.uniform(ks[8], (B_HEADS,))
    b_w_q = nrm(ks[9], (n_b, d, d)) * s
    b_w_o = nrm(ks[10], (n_b, d, d)) * (s * BETA)
    router_w = nrm(ks[11], (d, N_EXPERTS)) * s
    router_b = 0.01 * nrm(ks[12], (N_EXPERTS,))
    moe_w_gate = nrm(ks[13], (DEPTH, N_EXPERTS, d, D_FF)) * s
    moe_w_up = nrm(ks[14], (DEPTH, N_EXPERTS, d, D_FF)) * (s * BETA)
    moe_w_down = nrm(ks[15], (DEPTH, N_EXPERTS, D_FF, d)) * (D_FF ** -0.5 * BETA)
    ln_gain = 1.0 + 0.02 * nrm(ks[16], (DEPTH, 2, d))
    ln_bias = 0.02 * nrm(ks[17], (DEPTH, 2, d))
    return {"x": x, "a_w_qkv": a_w_qkv, "a_rel_bias": a_rel_bias, "a_w_o": a_w_o,
            "kv_w": kv_w, "fg_w": fg_w, "fg_b": fg_b, "b_w_q": b_w_q, "b_w_o": b_w_o,
            "router_w": router_w, "router_b": router_b, "moe_w_gate": moe_w_gate,
            "moe_w_up": moe_w_up, "moe_w_down": moe_w_down, "ln_gain": ln_gain,
            "ln_bias": ln_bias}


def reference(x, a_w_qkv, a_rel_bias, a_w_o, kv_w, fg_w, fg_b, b_w_q, b_w_o,
              router_w, router_b, moe_w_gate, moe_w_up, moe_w_down, ln_gain, ln_bias):
    b, s, d = x.shape
    k_sh = v_sh = f_sh = None
    for layer in range(DEPTH):
        if layer < N_A_LAYERS:
            h = chunk_relpos_attention(x, a_w_qkv[layer], a_rel_bias[layer], a_w_o[layer])
        else:
            lb = layer - N_A_LAYERS
            h = forgetting_attention(x, b_w_q[lb], b_w_o[lb], k_sh, v_sh, f_sh)
        x = layer_norm(ALPHA * x + h, ln_gain[layer, 0], ln_bias[layer, 0])
        xt = x.reshape(b * s, d)
        experts, gates = grouped_top2_route(xt, router_w, router_b)
        y = moe_ffn(xt, experts, gates, moe_w_gate[layer], moe_w_up[layer], moe_w_down[layer])
        x = layer_norm(ALPHA * x + y.reshape(b, s, d), ln_gain[layer, 1], ln_bias[layer, 1])
        if layer == N_A_LAYERS - 1:
            k_sh, v_sh, f_sh = shared_kv_side(x, kv_w, fg_w, fg_b)
    return x
```

```cpp
#include <hip/hip_runtime.h>
#include <cstdio>
#include <cstdint>
#ifndef MK_N_LAUNCHES
#define MK_N_LAUNCHES 17
#endif
namespace pg8 {
#define PG8_LAS __attribute__((address_space(3)))
typedef unsigned short bf16_t;
typedef short bf16x8 __attribute__((ext_vector_type(8)));
typedef float f32x4 __attribute__((ext_vector_type(4)));
typedef unsigned u32x4 __attribute__((ext_vector_type(4)));
constexpr int BM = 256, BK = 64, HALF = 128, HTB = HALF * BK * 2  , STAGE_BYTES = 8 * HTB, NXCD = 8, WGM = 8;

__host__ __device__ __forceinline__ int lds_byte(int r, int c) { const int st = (r >> 4) * 2 + (c >> 5), rr = r & 15, cc = c & 31, ob = rr * 64 + cc * 2; return st * 1024 + (ob ^ (((ob >> 9) & 1) << 5)); }
__host__ __device__ __forceinline__ void stage_rc(int b, int& R, int& C) { const int st = b / 1024, sb = b % 1024, swz = sb ^ (((sb >> 9) & 1) << 5); R = (st >> 1) * 16 + swz / 64; C = (st & 1) * 32 + (swz % 64) / 2; }
__host__ __device__ __forceinline__ int perm32(int rho) { const int n = rho >> 4, i = rho & 15; return 8 * (i >> 2) + 4 * n + (i & 3); }

struct Unit { int pm, pn; size_t boff; };
struct Gemm { const bf16_t* A; const bf16_t* Bt; int M, N, K; };

struct StaticOrder {
    int nM, nN, nwg, G, c;
    __host__ __device__ void init(int M, int N, int G_, int c_) { nM = M / BM; nN = N / BM; nwg = nM * nN; G = G_; c = c_; }
    __host__ __device__ bool next(int i, Unit& u) const {
        const long L = (long)i * G + c; if (L >= nwg) return false;
        int wgid = (int)L; { const int q = nwg / NXCD, r = nwg % NXCD, xcd = wgid % NXCD, off = wgid / NXCD; wgid = (xcd < r ? xcd * (q + 1) : r * (q + 1) + (xcd - r) * q) + off; }
        const int nig = WGM * nN, gid = wgid / nig, fm = gid * WGM, gsz = (nM - fm) < WGM ? (nM - fm) : WGM;
        u.pm = fm + ((wgid % nig) % gsz); u.pn = (wgid % nig) / gsz; u.boff = 0; return true;
    }
    __device__ __forceinline__ void a_ready(const Unit&) const {}
    __device__ __forceinline__ void done(const Unit&) const {}
};

__device__ __forceinline__ unsigned cvt_pk_bf16(float lo, float hi) { unsigned r; asm volatile("v_cvt_pk_bf16_f32 %0, %1, %2" : "=v"(r) : "v"(lo), "v"(hi)); return r; }
typedef float f32x2 __attribute__((ext_vector_type(2)));
__device__ __forceinline__ f32x2 gelu_pk(f32x2 v) {
    const f32x2 av = __builtin_elementwise_abs(v), d = av * 0.2316418882f + 1.0f;
    f32x2 t; t.x = __builtin_amdgcn_rcpf(d.x); t.y = __builtin_amdgcn_rcpf(d.y);
    f32x2 q = t * 0.5307027145f + (-0.7265760135f); q = q * t + 0.7107068705f; q = q * t + (-0.142248368f); q = q * t + 0.127414796f; q = q * t;
    const f32x2 s = (v * v) * (-0.72134752044f);
    f32x2 e; e.x = __builtin_amdgcn_exp2f(s.x); e.y = __builtin_amdgcn_exp2f(s.y);
    const f32x2 m = v * (q * e), r = v - m;
    f32x2 o; o.x = v.x < 0.f ? m.x : r.x; o.y = v.y < 0.f ? m.y : r.y; return o;
}

template <int ACT  > struct EpiBf16 {
    static constexpr bool PERM = true, AFTER_DRAIN = false; static_assert(ACT == 0 || ACT == 1, "EpiBf16: ACT is 0 (none) or 1 (gelu_pk)");
    bf16_t* O; int ldc; const float* bias; int split_cols; size_t split_stride; float scale0;
    __device__ __forceinline__ void operator()(const f32x4 (&acc)[2][2][4][2], const Unit& u, int wr, int wc, int fr, int fq) const {
        const int row0 = u.pm * BM + wr * 64 + fr; int colt = u.pn * BM; bf16_t* base = O;
        float sc = 1.f; if (split_cols) { const int t = colt / split_cols; base += (size_t)t * split_stride; colt -= t * split_cols; if (t == 0) sc = scale0; }
        const int col0 = colt + wc * 32 + 8 * fq, bcol0 = u.pn * BM + wc * 32 + 8 * fq;
        f32x4 bv[2][2];
#pragma unroll
        for (int bj = 0; bj < 2; ++bj)
#pragma unroll
            for (int n = 0; n < 2; ++n) bv[bj][n] = bias ? *(const f32x4*)(bias + bcol0 + bj * HALF + 4 * n) : (f32x4){0.f, 0.f, 0.f, 0.f};
#pragma unroll
        for (int ai = 0; ai < 2; ++ai)
#pragma unroll
            for (int m = 0; m < 4; ++m) { bf16_t* rowp = base + (size_t)(row0 + ai * HALF + m * 16) * ldc + col0;
#pragma unroll
                for (int bj = 0; bj < 2; ++bj) { f32x4 v0 = acc[ai][bj][m][0] + bv[bj][0], v1 = acc[ai][bj][m][1] + bv[bj][1];
                    if (ACT == 1) { f32x2 a = gelu_pk((f32x2){v0[0], v0[1]}), b = gelu_pk((f32x2){v0[2], v0[3]}), c = gelu_pk((f32x2){v1[0], v1[1]}), d = gelu_pk((f32x2){v1[2], v1[3]});
                        v0 = (f32x4){a.x, a.y, b.x, b.y}; v1 = (f32x4){c.x, c.y, d.x, d.y}; }
                    v0 = v0 * sc; v1 = v1 * sc; u32x4 w; w.x = cvt_pk_bf16(v0[0], v0[1]); w.y = cvt_pk_bf16(v0[2], v0[3]); w.z = cvt_pk_bf16(v1[0], v1[1]); w.w = cvt_pk_bf16(v1[2], v1[3]);
                    *(u32x4*)(rowp + bj * HALF) = w; } }
    }
};
struct EpiResF32 {
    static constexpr bool PERM = false, AFTER_DRAIN = false;
    const float* res; float* out; float alpha;
    __device__ __forceinline__ void operator()(const f32x4 (&acc)[2][2][4][2], const Unit& u, int wr, int wc, int fr, int fq) const {
        const int col0 = u.pn * BM + wc * 32 + 4 * fq;
#pragma unroll
        for (int ai = 0; ai < 2; ++ai)
#pragma unroll
            for (int m = 0; m < 4; ++m) { const size_t off = (size_t)(u.pm * BM + ai * HALF + wr * 64 + m * 16 + fr) * 2048 + col0;
#pragma unroll
                for (int bj = 0; bj < 2; ++bj)
#pragma unroll
                    for (int n = 0; n < 2; ++n) { const f32x4 x = *(const f32x4*)(res + off + bj * HALF + n * 16); const f32x4 o = x * alpha + acc[ai][bj][m][n]; *(f32x4*)(out + off + bj * HALF + n * 16) = o; }
                if (m & 1) asm volatile("" ::: "memory"); }
    }
};
struct EpiSwiGLU {
    static constexpr bool PERM = true, AFTER_DRAIN = false;
    bf16_t* H;
    __device__ __forceinline__ static float swi(float g, float u) { const float e = __builtin_amdgcn_exp2f(g * -1.4426950408889634f); return g * __builtin_amdgcn_rcpf(1.0f + e) * u; }
    __device__ __forceinline__ void operator()(const f32x4 (&acc)[2][2][4][2], const Unit& u, int wr, int wc, int fr, int fq) const {
        const int row0 = u.pm * BM + wr * 64 + fr, col0 = u.pn * HALF + wc * 32 + 8 * fq;
#pragma unroll
        for (int ai = 0; ai < 2; ++ai)
#pragma unroll
            for (int m = 0; m < 4; ++m) { bf16_t* rowp = H + (size_t)(row0 + ai * HALF + m * 16) * 2048 + col0;
                const f32x4 g0 = acc[ai][0][m][0], g1 = acc[ai][0][m][1], u0 = acc[ai][1][m][0], u1 = acc[ai][1][m][1];
                u32x4 w; w.x = cvt_pk_bf16(swi(g0[0], u0[0]), swi(g0[1], u0[1])); w.y = cvt_pk_bf16(swi(g0[2], u0[2]), swi(g0[3], u0[3]));
                w.z = cvt_pk_bf16(swi(g1[0], u1[0]), swi(g1[1], u1[1])); w.w = cvt_pk_bf16(swi(g1[2], u1[2]), swi(g1[3], u1[3]));
                *(u32x4*)rowp = w; }
    }
};
struct EpiGateBf16 {
    static constexpr bool PERM = true, AFTER_DRAIN = false;
    bf16_t* Y; const float* gate;
    __device__ __forceinline__ void operator()(const f32x4 (&acc)[2][2][4][2], const Unit& u, int wr, int wc, int fr, int fq) const {
        const int row0 = u.pm * BM + wr * 64 + fr, col0 = u.pn * BM + wc * 32 + 8 * fq;
#pragma unroll
        for (int ai = 0; ai < 2; ++ai)
#pragma unroll
            for (int m = 0; m < 4; ++m) { const int r = row0 + ai * HALF + m * 16; const float gt = gate[r]; bf16_t* rowp = Y + (size_t)r * 2048 + col0;
#pragma unroll
                for (int bj = 0; bj < 2; ++bj) { const f32x4 v0 = acc[ai][bj][m][0] * gt, v1 = acc[ai][bj][m][1] * gt;
                    u32x4 w; w.x = cvt_pk_bf16(v0[0], v0[1]); w.y = cvt_pk_bf16(v0[2], v0[3]); w.z = cvt_pk_bf16(v1[0], v1[1]); w.w = cvt_pk_bf16(v1[2], v1[3]);
                    *(u32x4*)(rowp + bj * HALF) = w; } }
    }
};
struct MoeOrder {
    int nM, nN, nwg, G, c; const PG8_LAS int* blk_exp; size_t estride;
    __device__ __forceinline__ void init(int nblk, int N, int G_, int c_, const PG8_LAS int* be, size_t es) { nM = nblk; nN = N / BM; nwg = nM * nN; G = G_; c = c_; blk_exp = be; estride = es; }
    __device__ __forceinline__ bool next(int i, Unit& u) const {
        const long L = (long)i * G + c; if (L >= nwg) return false;
        int wgid = (int)L; { const int q = nwg / NXCD, r = nwg % NXCD, xcd = wgid % NXCD, off = wgid / NXCD; wgid = (xcd < r ? xcd * (q + 1) : r * (q + 1) + (xcd - r) * q) + off; }
        const int nig = WGM * nN, gid = wgid / nig, fm = gid * WGM, gsz = (nM - fm) < WGM ? (nM - fm) : WGM;
        u.pm = fm + ((wgid % nig) % gsz); u.pn = (wgid % nig) / gsz;
        u.boff = (size_t)__builtin_amdgcn_readfirstlane(blk_exp[u.pm]) * estride; return true;
    }
    __device__ __forceinline__ void a_ready(const Unit&) const {}
    __device__ __forceinline__ void done(const Unit&) const {}
};
template <class Epi, class Sched, bool ALIGN_EPI = false, bool SP2 = false>
__device__ __forceinline__ void gemm_phase(PG8_LAS unsigned char* lds, const Gemm g, const Sched& S, const Epi& E, const int tid) {
    const int wid = __builtin_amdgcn_readfirstlane(tid >> 6), lane = tid & 63, wr = wid >> 2, wc = wid & 3, fr = lane & 15, fq = lane >> 4;
    const int K = g.K, nt = K / BK;
    unsigned voffA[2], voffB[2];
#pragma unroll
    for (int i = 0; i < 2; ++i) { int R, C; stage_rc(tid * 16 + i * 8192, R, C); const int Rb = Epi::PERM ? ((R & ~31) + perm32(R & 31)) : R;
        voffA[i] = (unsigned)(R * K + C) * 2u; voffB[i] = (unsigned)(Rb * K + C) * 2u; }
    const size_t kstep = (size_t)(BK * 2);
    const size_t hstep = (size_t)HALF * K * 2;
    const size_t tstep = 2 * hstep;
    const unsigned ldsw = (unsigned)wid * 1024u;
    const int aoff = lds_byte(wr * 64 + fr, fq * 8), boff = lds_byte(wc * 32 + fr, fq * 8);
#define PG8_SA(b, h) (((b) * 2 + (h)) * HTB)
#define PG8_SB(b, h) ((4 + (b) * 2 + (h)) * HTB)
#define PG8_STAGE(bufoff, gbase, voff) do { _Pragma("unroll") for (int _i = 0; _i < 2; ++_i) \
        __builtin_amdgcn_global_load_lds((const unsigned*)((const char*)(gbase) + (voff)[_i]), (PG8_LAS unsigned*)(lds + (bufoff) + ldsw + _i * 8192), 16, 0, 0); } while (0)
#define PG8_LDA(dst, b, h) do { _Pragma("unroll") for (int m = 0; m < 4; ++m) _Pragma("unroll") for (int k = 0; k < 2; ++k) dst[m][k] = *(const PG8_LAS bf16x8*)(lds + PG8_SA(b, h) + aoff + m * 2048 + k * 1024); } while (0)
#define PG8_LDB(dst, b, h) do { _Pragma("unroll") for (int n = 0; n < 2; ++n) _Pragma("unroll") for (int k = 0; k < 2; ++k) dst[n][k] = *(const PG8_LAS bf16x8*)(lds + PG8_SB(b, h) + boff + n * 2048 + k * 1024); } while (0)
#define PG8_MMA(ai, bj, At, Bt) do { __builtin_amdgcn_s_setprio(1); _Pragma("unroll") for (int m = 0; m < 4; ++m) _Pragma("unroll") for (int n = 0; n < 2; ++n) _Pragma("unroll") for (int k = 0; k < 2; ++k) \
        acc[ai][bj][m][n] = __builtin_amdgcn_mfma_f32_16x16x32_bf16(Bt[n][k], At[m][k], acc[ai][bj][m][n], 0, 0, 0); __builtin_amdgcn_s_setprio(0); } while (0)
#define PG8_WAIT_V(n) asm volatile("s_waitcnt vmcnt(" #n ")" ::: "memory")
#define PG8_WAIT_L(n) asm volatile("s_waitcnt lgkmcnt(" #n ")" ::: "memory")
#define PG8_BAR __builtin_amdgcn_s_barrier()
#define PG8_SCHED __builtin_amdgcn_sched_barrier(0)
    Unit cur, nxt; int ui = 0;
    if (!S.next(0, cur)) return;
    f32x4 acc[2][2][4][2];
#pragma unroll
    for (int a = 0; a < 2; ++a)
#pragma unroll
        for (int b = 0; b < 2; ++b)
#pragma unroll
            for (int m = 0; m < 4; ++m)
#pragma unroll
                for (int n = 0; n < 2; ++n) acc[a][b][m][n] = (f32x4){0.f, 0.f, 0.f, 0.f};
    bf16x8 At[4][2], B0[2][2], B1[2][2];
    const char* cA = (const char*)g.A + (size_t)cur.pm * tstep; const char* cB = (const char*)g.Bt + cur.boff + (size_t)cur.pn * tstep;
    S.a_ready(cur);
    if constexpr (SP2) {
        PG8_STAGE(PG8_SB(0, 0), cB, voffB); PG8_STAGE(PG8_SB(0, 1), cB + hstep, voffB); PG8_STAGE(PG8_SA(0, 0), cA, voffA); PG8_STAGE(PG8_SA(0, 1), cA + hstep, voffA);
        if (wr == 1) PG8_BAR;
        PG8_WAIT_V(2); PG8_BAR;
        PG8_STAGE(PG8_SB(1, 0), cB + kstep, voffB); PG8_STAGE(PG8_SA(1, 0), cA + kstep, voffA); PG8_STAGE(PG8_SB(1, 1), cB + hstep + kstep, voffB);
        PG8_WAIT_V(6); PG8_BAR;
    } else {
        PG8_STAGE(PG8_SB(0, 0), cB, voffB); PG8_STAGE(PG8_SA(0, 0), cA, voffA); PG8_STAGE(PG8_SB(0, 1), cB + hstep, voffB); PG8_STAGE(PG8_SA(0, 1), cA + hstep, voffA);
        if (wr == 1) PG8_BAR;
        PG8_WAIT_V(4); PG8_BAR;
        PG8_STAGE(PG8_SB(1, 0), cB + kstep, voffB); PG8_STAGE(PG8_SA(1, 0), cA + kstep, voffA); PG8_STAGE(PG8_SB(1, 1), cB + hstep + kstep, voffB);
        PG8_WAIT_V(6); PG8_BAR;
    }
    for (;;) {
        const bool has_next = S.next(ui + 1, nxt);
        const char* nA = has_next ? (const char*)g.A + (size_t)nxt.pm * tstep : cA; const char* nB = has_next ? (const char*)g.Bt + nxt.boff + (size_t)nxt.pn * tstep : cB;
        for (int t = 0; t < nt; t += 2) {
            const bool last = (t == nt - 2);
            const char* a1 = cA + (size_t)(t + 1) * kstep;
            const char* a2 = last ? nA : cA + (size_t)(t + 2) * kstep; const char* b2 = last ? nB : cB + (size_t)(t + 2) * kstep;
            const char* a3 = a2 + kstep; const char* b3 = b2 + kstep;
            if (last && has_next) S.a_ready(nxt);
            if constexpr (SP2) {
            PG8_LDB(B0, 0, 0); PG8_LDB(B1, 0, 1); PG8_SCHED; PG8_LDA(At, 0, 0); PG8_STAGE(PG8_SA(1, 1), a1 + hstep, voffA);
            PG8_WAIT_V(8); PG8_WAIT_L(0); PG8_BAR; PG8_MMA(0, 0, At, B0); PG8_MMA(0, 1, At, B1); PG8_BAR; PG8_SCHED;
            PG8_LDA(At, 0, 1); PG8_STAGE(PG8_SB(0, 0), b2, voffB); PG8_STAGE(PG8_SB(0, 1), b2 + hstep, voffB); PG8_STAGE(PG8_SA(0, 0), a2, voffA);
            PG8_WAIT_V(8); PG8_WAIT_L(0); PG8_BAR; PG8_MMA(1, 0, At, B0); PG8_MMA(1, 1, At, B1); PG8_BAR; PG8_SCHED;
            PG8_LDB(B0, 1, 0); PG8_LDB(B1, 1, 1); PG8_SCHED; PG8_LDA(At, 1, 0); PG8_STAGE(PG8_SA(0, 1), a2 + hstep, voffA);
            PG8_WAIT_V(8); PG8_WAIT_L(0); PG8_BAR; PG8_MMA(0, 0, At, B0); PG8_MMA(0, 1, At, B1); PG8_BAR; PG8_SCHED;
            PG8_LDA(At, 1, 1); PG8_STAGE(PG8_SB(1, 0), b3, voffB); PG8_STAGE(PG8_SB(1, 1), b3 + hstep, voffB); PG8_STAGE(PG8_SA(1, 0), a3, voffA);
            PG8_WAIT_V(8); PG8_WAIT_L(0); PG8_BAR; PG8_MMA(1, 0, At, B0); PG8_MMA(1, 1, At, B1); PG8_BAR; PG8_SCHED;
            } else {
            PG8_LDB(B0, 0, 0); PG8_SCHED; PG8_LDA(At, 0, 0); PG8_STAGE(PG8_SA(1, 1), a1 + hstep, voffA);
            PG8_WAIT_L(8); PG8_BAR; PG8_WAIT_L(0); PG8_MMA(0, 0, At, B0); PG8_BAR; PG8_SCHED;
            PG8_LDB(B1, 0, 1); PG8_STAGE(PG8_SB(0, 0), b2, voffB);
            PG8_BAR; PG8_WAIT_L(0); PG8_MMA(0, 1, At, B1); PG8_BAR;
            PG8_LDA(At, 0, 1); PG8_STAGE(PG8_SA(0, 0), a2, voffA);
            PG8_BAR; PG8_WAIT_L(0); PG8_MMA(1, 0, At, B0); PG8_BAR; PG8_SCHED;
            PG8_STAGE(PG8_SB(0, 1), b2 + hstep, voffB);
            PG8_WAIT_V(6); PG8_BAR; PG8_MMA(1, 1, At, B1); PG8_BAR;
            PG8_LDB(B0, 1, 0); PG8_SCHED; PG8_LDA(At, 1, 0); PG8_STAGE(PG8_SA(0, 1), a2 + hstep, voffA);
            PG8_WAIT_L(8); PG8_BAR; PG8_WAIT_L(0); PG8_MMA(0, 0, At, B0); PG8_BAR; PG8_SCHED;
            PG8_LDB(B1, 1, 1); PG8_STAGE(PG8_SB(1, 0), b3, voffB);
            PG8_BAR; PG8_WAIT_L(0); PG8_MMA(0, 1, At, B1); PG8_BAR;
            PG8_LDA(At, 1, 1); PG8_STAGE(PG8_SA(1, 0), a3, voffA);
            PG8_BAR; PG8_WAIT_L(0); PG8_MMA(1, 0, At, B0); PG8_BAR; PG8_SCHED;
            PG8_STAGE(PG8_SB(1, 1), b3 + hstep, voffB);
            PG8_WAIT_V(6); PG8_BAR; PG8_MMA(1, 1, At, B1); PG8_BAR;
            }
        }
        if constexpr (ALIGN_EPI) { if (wr == 0) PG8_BAR; }
        if constexpr (!Epi::AFTER_DRAIN) { E(acc, cur, wr, wc, fr, fq); S.done(cur); }
        if (!has_next) break;
#pragma unroll
        for (int a = 0; a < 2; ++a)
#pragma unroll
            for (int b = 0; b < 2; ++b)
#pragma unroll
                for (int m = 0; m < 4; ++m)
#pragma unroll
                    for (int n = 0; n < 2; ++n) acc[a][b][m][n] = (f32x4){0.f, 0.f, 0.f, 0.f};
        cur = nxt; cA = nA; cB = nB; ++ui;
        if constexpr (ALIGN_EPI) { if (wr == 1) PG8_BAR; }
    }
    PG8_WAIT_V(0);
    if constexpr (!ALIGN_EPI) { if (wr == 0) PG8_BAR; }
    PG8_BAR;
    if constexpr (Epi::AFTER_DRAIN) { E.fused(acc, cur, wr, wc, fr, fq, lds, wid, lane); S.done(cur); }
#undef PG8_SA
#undef PG8_SB
#undef PG8_STAGE
#undef PG8_LDA
#undef PG8_LDB
#undef PG8_MMA
#undef PG8_WAIT_V
#undef PG8_WAIT_L
#undef PG8_BAR
#undef PG8_SCHED
}
}
namespace att {
typedef unsigned short bf16_t;
typedef short bf16x8 __attribute__((ext_vector_type(8)));
typedef short s16x4 __attribute__((ext_vector_type(4)));
typedef float f32x16 __attribute__((ext_vector_type(16)));
typedef float f32x4 __attribute__((ext_vector_type(4)));
typedef unsigned u32x4 __attribute__((ext_vector_type(4)));
constexpr int NW = 8, QBLK = 32, KVBLK = 64, PITCH = 2048;
constexpr int SHM_V = KVBLK * 128 * 2, SHM_K = KVBLK * 128 * 2;
constexpr int OFF_WS = 2 * SHM_V + 2 * SHM_K;
constexpr int OFF_FK = OFF_WS + NW * 64 * 4;
constexpr int OFF_TAB = OFF_FK + 2 * 64 * 4;
constexpr int LDS_BYTES = OFF_TAB + 2 * 260 * 4;
constexpr float THR = 8.f;
#define ATT_GAS __attribute__((address_space(1)))
template <class T> __device__ __forceinline__ T ldg(const void* base, unsigned boff) { return *(const ATT_GAS T*)((const ATT_GAS char*)base + boff); }
template <class T> __device__ __forceinline__ void stg(void* base, unsigned boff, T v) { *(ATT_GAS T*)((ATT_GAS char*)base + boff) = v; }
#define KSWZ(row, colB) ((row) * 256 + ((colB) ^ (((row) & 7) << 4)))
#define SBAR() __builtin_amdgcn_sched_barrier(0)
__device__ __forceinline__ int v_st(int k, int c) { const int kk = (k & ~0xC) | ((k & 4) << 1) | ((k & 8) >> 1); return ((kk >> 3) * 4 + (c >> 5)) * 512 + ((kk & 7) * 32 + (c & 31)) * 2; }
__device__ __forceinline__ int v_rd_base(int lane) { return ((lane & 3) << 3) | (((lane >> 2) & 3) << 6) | (((lane >> 4) & 1) << 5) | (((lane >> 5) & 1) << 8); }
constexpr int v_rd_off(int d0, int ks, int half) { return d0 * 512 + ks * 4096 + half * 2048; }
__device__ __forceinline__ int crow(int r, int hi) { return (r & 3) + 8 * (r >> 2) + 4 * hi; }
__device__ __forceinline__ unsigned cvtpk(float lo, float hi) { unsigned r; asm volatile("v_cvt_pk_bf16_f32 %0, %1, %2" : "=v"(r) : "v"(lo), "v"(hi)); return r; }
__device__ __forceinline__ void mask_tile(f32x16& p0, f32x16& p1, int dq) {
    const float NEG = -__builtin_inff();
#pragma unroll
    for (int r = 0; r < 16; ++r) { const int c = (r & 3) + 8 * (r >> 2);
        if (dq - c < 0) p0[r] = NEG;
        if (dq - c - 32 < 0) p1[r] = NEG; }
}
template <int MODE> __device__ __forceinline__ void partialSM(f32x16& p0, f32x16& p1, float& m_reg, float& mn, float& alpha) {
    constexpr float SCALE = MODE == 0 ? 0.08838834764831845f : 0.125f;
    float pmax = p0[0];
#pragma unroll
    for (int r = 1; r < 16; ++r) pmax = fmaxf(pmax, p0[r]);
#pragma unroll
    for (int r = 0; r < 16; ++r) pmax = fmaxf(pmax, p1[r]);
    { auto rr = __builtin_amdgcn_permlane32_swap(__float_as_uint(pmax), __float_as_uint(pmax), false, false);
      pmax = fmaxf(__uint_as_float(rr[0]), __uint_as_float(rr[1])); }
    constexpr float C2 = 1.4426950408889634f * SCALE;
    if (__builtin_expect(__all((pmax - m_reg) * SCALE <= THR), 1)) { mn = m_reg; alpha = 1.f; }
    else { mn = fmaxf(m_reg, pmax); alpha = __builtin_amdgcn_exp2f((m_reg - mn) * C2); m_reg = mn; }
    const float mnL = -mn * C2;
#pragma unroll
    for (int r = 0; r < 16; ++r) p0[r] = fmaf(p0[r], C2, mnL);
#pragma unroll
    for (int r = 0; r < 16; ++r) p1[r] = fmaf(p1[r], C2, mnL);
#pragma unroll
    for (int r = 0; r < 16; ++r) p0[r] = __builtin_amdgcn_exp2f(p0[r]);
}
__device__ __forceinline__ void finishSM(f32x16& p0, f32x16& p1, float alpha, float& l_reg, bf16x8& pa0, bf16x8& pa1, bf16x8& pa2, bf16x8& pa3) {
#pragma unroll
    for (int r = 0; r < 16; ++r) p1[r] = __builtin_amdgcn_exp2f(p1[r]);
    float ps = 0;
#pragma unroll
    for (int r = 0; r < 16; ++r) ps += p0[r];
#pragma unroll
    for (int r = 0; r < 16; ++r) ps += p1[r];
    { auto rr = __builtin_amdgcn_permlane32_swap(__float_as_uint(ps), __float_as_uint(ps), false, false);
      ps = __uint_as_float(rr[0]) + __uint_as_float(rr[1]); }
    l_reg = l_reg * alpha + ps;
#define PK4(P, B_, OUT) do { unsigned a0 = cvtpk(P[B_+0], P[B_+1]), a1 = cvtpk(P[B_+2], P[B_+3]);                          \
        unsigned b0 = cvtpk(P[B_+4], P[B_+5]), b1 = cvtpk(P[B_+6], P[B_+7]);                                             \
        auto r0 = __builtin_amdgcn_permlane32_swap(a0, b0, false, false); auto r1 = __builtin_amdgcn_permlane32_swap(a1, b1, false, false); \
        u32x4 w = {r0[0], r1[0], r0[1], r1[1]}; OUT = *reinterpret_cast<bf16x8*>(&w); } while (0)
    PK4(p0, 0, pa0); PK4(p0, 8, pa1); PK4(p1, 0, pa2); PK4(p1, 8, pa3);
#undef PK4
}
struct BiasCtx { float fq; int qi128; int cw; int hd; };
template <int KB, int MODE>
__device__ __forceinline__ void qkt(f32x16& p0, f32x16& p1, const char* lds, int r32, int hi, const bf16x8* qr, bool act, const BiasCtx& bc, int jt) {
    if (MODE == 1 && !act) { const float NEG = -__builtin_inff();
#pragma unroll
        for (int r = 0; r < 16; ++r) { p0[r] = NEG; p1[r] = NEG; } return; }
    if constexpr (MODE == 0) {
        const float* fk = (const float*)(lds + OFF_FK + KB * 256);
#pragma unroll
        for (int g = 0; g < 4; ++g) { const f32x4 f = *(const f32x4*)(fk + 8 * g + 4 * hi);
            p0[4 * g + 0] = bc.fq - f[0]; p0[4 * g + 1] = bc.fq - f[1]; p0[4 * g + 2] = bc.fq - f[2]; p0[4 * g + 3] = bc.fq - f[3]; }
#pragma unroll
        for (int g = 0; g < 4; ++g) { const f32x4 f = *(const f32x4*)(fk + 32 + 8 * g + 4 * hi);
            p1[4 * g + 0] = bc.fq - f[0]; p1[4 * g + 1] = bc.fq - f[1]; p1[4 * g + 2] = bc.fq - f[2]; p1[4 * g + 3] = bc.fq - f[3]; }
    } else {
        const float* tab = (const float*)(lds + OFF_TAB) + bc.hd * 260;
        const int delta = bc.cw - jt;
        if (delta >= 3) { const float c = tab[256];
#pragma unroll
            for (int r = 0; r < 16; ++r) { p0[r] = c; p1[r] = c; } }
        else { const int base = 64 * delta + bc.qi128 - 4 * hi;
#pragma unroll
            for (int r = 0; r < 16; ++r) { const int kj = (r & 3) + 8 * (r >> 2); int i0 = base - kj, i1 = base - kj - 32; i0 = i0 > 256 ? 256 : i0; i1 = i1 > 256 ? 256 : i1;
                p0[r] = tab[i0]; p1[r] = tab[i1]; } }
    }
    const char* K_lds = lds + 2 * SHM_V;
    const char* kb[4];
#pragma unroll
    for (int dd = 0; dd < 4; ++dd) kb[dd] = K_lds + KB * SHM_K + KSWZ(r32, (dd * 16 + hi * 8) * 2);
    if constexpr (MODE == 0) {
#pragma unroll
        for (int d0 = 0; d0 < 8; ++d0) { const char* a = kb[d0 & 3] + (d0 >> 2) * 128;
            const bf16x8 b0 = *reinterpret_cast<const bf16x8*>(a);
            const bf16x8 b1 = *reinterpret_cast<const bf16x8*>(a + 32 * 256);
            p0 = __builtin_amdgcn_mfma_f32_32x32x16_bf16(b0, qr[d0], p0, 0, 0, 0);
            p1 = __builtin_amdgcn_mfma_f32_32x32x16_bf16(b1, qr[d0], p1, 0, 0, 0); }
    } else {
#pragma unroll
        for (int dd = 0; dd < 4; ++dd) { const char* a = kb[dd] + bc.hd * 128;
            const bf16x8 b0 = *reinterpret_cast<const bf16x8*>(a);
            const bf16x8 b1 = *reinterpret_cast<const bf16x8*>(a + 32 * 256);
            p0 = __builtin_amdgcn_mfma_f32_32x32x16_bf16(b0, qr[dd], p0, 0, 0, 0);
            p1 = __builtin_amdgcn_mfma_f32_32x32x16_bf16(b1, qr[dd], p1, 0, 0, 0); }
    }
}
template <int VB, int ND>
__device__ __forceinline__ void pv_tile(f32x16* o, int vb0, bf16x8 pa0, bf16x8 pa1, bf16x8 pa2, bf16x8 pa3, bool act) {
    if (!act) return;
#define TRRD(dst, off) asm volatile("ds_read_b64_tr_b16 %0, %1 offset:%2" : "=&v"(dst) : "v"(vb0), "i"(off) : "memory")
#define PV_D0(d0) do { s16x4 l0, l1, l2, l3, h0, h1, h2, h3; constexpr int b_ = VB * SHM_V + v_rd_off(d0, 0, 0);   \
        TRRD(l0, b_); TRRD(h0, b_ + 2048); TRRD(l1, b_ + 4096); TRRD(h1, b_ + 6144); TRRD(l2, b_ + 8192); TRRD(h2, b_ + 10240); TRRD(l3, b_ + 12288); TRRD(h3, b_ + 14336); \
        asm volatile("s_waitcnt lgkmcnt(0)" ::: "memory"); SBAR();   \
        o[d0] = __builtin_amdgcn_mfma_f32_32x32x16_bf16(pa0, (bf16x8){l0[0], l0[1], l0[2], l0[3], h0[0], h0[1], h0[2], h0[3]}, o[d0], 0, 0, 0);   \
        o[d0] = __builtin_amdgcn_mfma_f32_32x32x16_bf16(pa1, (bf16x8){l1[0], l1[1], l1[2], l1[3], h1[0], h1[1], h1[2], h1[3]}, o[d0], 0, 0, 0);   \
        o[d0] = __builtin_amdgcn_mfma_f32_32x32x16_bf16(pa2, (bf16x8){l2[0], l2[1], l2[2], l2[3], h2[0], h2[1], h2[2], h2[3]}, o[d0], 0, 0, 0);   \
        o[d0] = __builtin_amdgcn_mfma_f32_32x32x16_bf16(pa3, (bf16x8){l3[0], l3[1], l3[2], l3[3], h3[0], h3[1], h3[2], h3[3]}, o[d0], 0, 0, 0); } while (0)
    PV_D0(0); PV_D0(1);
    if constexpr (ND == 4) { PV_D0(2); PV_D0(3); }
#undef PV_D0
#undef TRRD
}
struct Blk { const bf16_t* Q; const bf16_t* K; const bf16_t* V; bf16_t* O; const float* F; const float* tab; int P0; int j_lo; };
template <int MODE>
__device__ __forceinline__ void attn_block(const Blk& cur, char* lds, const int tid) {
    constexpr int ND = MODE == 0 ? 4 : 2, NQ = MODE == 0 ? 8 : 4;
    constexpr float INVS = 11.313708498984761f;
    const int wid = __builtin_amdgcn_readfirstlane(tid >> 6), lane = tid & 63, r32 = lane & 31, hi = lane >> 5;
    const int hd = MODE == 1 ? (wid >> 2) : 0, rb = MODE == 1 ? (wid & 3) : wid;
    const int C0 = cur.P0 / KVBLK;
    int j_lo, j_hi;
    if (MODE == 0) { j_lo = cur.j_lo; j_hi = C0 + 4; } else { j_lo = C0 - 8 < 0 ? 0 : C0 - 8; j_hi = C0 + 2; }
    const int NT = j_hi - j_lo;
    const int qlo = cur.P0 + rb * QBLK, qm = qlo + r32 - 4 * hi;
    BiasCtx bc; bc.fq = 0.f; bc.hd = hd; bc.cw = C0 + (rb >> 1); bc.qi128 = (rb & 1) * 32 + r32 + 128;
    char* V_lds = lds; char* K_lds = lds + 2 * SHM_V;
    float* ws = (float*)(lds + OFF_WS) + wid * 64; float* li_l = ws; float* al_l = ws + 32;
    float m_reg = -1e30f, l_reg = 0; f32x16 o[ND];
#pragma unroll
    for (int d = 0; d < ND; ++d) o[d] = f32x16{};
    const int sr = tid >> 4, sc = (tid & 15) * 8, vst0 = v_st(sr, sc), vst1 = v_st(32 + sr, sc), kws = KSWZ(sr, sc * 2);
    const int vb0 = (int)(uintptr_t)V_lds + v_rd_base(lane) + hd * 1024;
    const bf16_t* Kh = cur.K; const bf16_t* Vh = cur.V;
    bf16x8 st_v0, st_v1, st_k0, st_k1; float st_f = 0.f, fref = 0.f;
    const unsigned goff0 = (unsigned)(sr * PITCH + sc) * 2u, goff1 = goff0 + 32u * PITCH * 2u;
#define VMW() asm volatile("s_waitcnt vmcnt(0)" ::: "memory")
#define SLOAD_H(k0) do { const bf16_t* vt_ = Vh + (size_t)(k0) * PITCH; const bf16_t* kt_ = Kh + (size_t)(k0) * PITCH;                \
                         st_v0 = ldg<bf16x8>(vt_, goff0); st_v1 = ldg<bf16x8>(vt_, goff1); st_k0 = ldg<bf16x8>(kt_, goff0); st_k1 = ldg<bf16x8>(kt_, goff1); \
                         if (MODE == 0 && wid == 0) st_f = ldg<float>(cur.F + (k0), (unsigned)lane * 4u); } while (0)
#define SWRITE_HK(bf) do { *(bf16x8*)(K_lds + (bf) * SHM_K + kws) = st_k0; *(bf16x8*)(K_lds + (bf) * SHM_K + kws + 32 * 256) = st_k1; \
                           if (MODE == 0 && wid == 0) *(float*)(lds + OFF_FK + (bf) * 256 + lane * 4) = (st_f - fref) * INVS; } while (0)
#define SWRITE_HV(bf) do { *(bf16x8*)(V_lds + (bf) * SHM_V + vst0) = st_v0; *(bf16x8*)(V_lds + (bf) * SHM_V + vst1) = st_v1; } while (0)
#define SWRITE_H(bf) do { SWRITE_HV(bf); SWRITE_HK(bf); } while (0)
#define RESC(a) do { if (__any((a) < 1.f)) { if (hi == 0) al_l[r32] = (a); asm volatile("s_waitcnt lgkmcnt(0)" ::: "memory");              \
                     _Pragma("unroll") for (int d_ = 0; d_ < ND; ++d_) _Pragma("unroll") for (int r = 0; r < 16; ++r) o[d_][r] *= al_l[crow(r, hi)]; } } while (0)
#define KBASE(t) ((j_lo + (t)) * KVBLK)
#define ACT(t) (MODE == 0 ? true : ((j_lo + (t)) >= bc.cw - 8 && (j_lo + (t)) <= bc.cw))
#define MASKT(P0_, P1_, t) do { if (MODE == 0) { const int kb_ = KBASE(t); if (kb_ + KVBLK - 1 > qlo) mask_tile(P0_, P1_, qm - kb_); } } while (0)
    bf16x8 qr[NQ];
    { const unsigned qoff = (unsigned)((rb * QBLK + r32) * PITCH + hd * 64 + hi * 8) * 2u;
#pragma unroll
      for (int d0 = 0; d0 < NQ; ++d0) qr[d0] = ldg<bf16x8>(cur.Q, qoff + d0 * 32u); }
    if constexpr (MODE == 0) { fref = ldg<float>(cur.F + cur.P0, 0u); bc.fq = (ldg<float>(cur.F + qlo, (unsigned)r32 * 4u) - fref) * INVS; }
    else { float* tab = (float*)(lds + OFF_TAB); for (int i = tid; i < 2 * 257; i += 64 * NW) { const int h2 = i >= 257 ? 1 : 0; tab[h2 * 260 + (i - h2 * 257)] = cur.tab[i] * 8.0f; } }
    SLOAD_H(KBASE(0)); VMW(); SWRITE_HK(0);
    __syncthreads();
    f32x16 pA0, pA1, pB0, pB1; float mnA, mnB, alA, alB; bf16x8 pa0, pa1, pa2, pa3;
    SWRITE_HV(0); SBAR();
    if (NT > 1) SLOAD_H(KBASE(1));
    SBAR(); qkt<0, MODE>(pA0, pA1, lds, r32, hi, qr, ACT(0), bc, j_lo);
    MASKT(pA0, pA1, 0); partialSM<MODE>(pA0, pA1, m_reg, mnA, alA);
    if (NT > 1) { VMW(); SWRITE_H(1); }
    __syncthreads();
#define HALF_STEP(PX0, PX1, mnX, alX, PY0, PY1, alY, t, KB, VB, SB) do {                                                      \
        SBAR(); qkt<KB, MODE>(PX0, PX1, lds, r32, hi, qr, ACT(t), bc, j_lo + (t));                                            \
        finishSM(PY0, PY1, alY, l_reg, pa0, pa1, pa2, pa3); SBAR();                                                           \
        if ((t) + 1 < NT) { SLOAD_H(KBASE((t) + 1)); SBAR(); }                                                               \
        pv_tile<VB, ND>(o, vb0, pa0, pa1, pa2, pa3, ACT((t) - 1)); MASKT(PX0, PX1, (t)); partialSM<MODE>(PX0, PX1, m_reg, mnX, alX);  \
        __syncthreads();                                                                                                      \
        if ((t) + 1 < NT) { VMW(); SWRITE_H(SB); }                                                                            \
        RESC(alX); __syncthreads(); } while (0)
    for (int t = 1; t + 1 < NT; t += 2) {
        HALF_STEP(pB0, pB1, mnB, alB, pA0, pA1, alA, t, 1, 0, 0);
        HALF_STEP(pA0, pA1, mnA, alA, pB0, pB1, alB, t + 1, 0, 1, 1);
    }
    const bool even = (NT & 1) == 0;
    if (even) { SBAR(); qkt<1, MODE>(pB0, pB1, lds, r32, hi, qr, ACT(NT - 1), bc, j_lo + NT - 1); SBAR(); }
    finishSM(pA0, pA1, alA, l_reg, pa0, pa1, pa2, pa3); SBAR();
    pv_tile<0, ND>(o, vb0, pa0, pa1, pa2, pa3, ACT(even ? NT - 2 : NT - 1));
    if (even) { MASKT(pB0, pB1, NT - 1); partialSM<MODE>(pB0, pB1, m_reg, mnB, alB); __syncthreads(); RESC(alB);
        finishSM(pB0, pB1, alB, l_reg, pa0, pa1, pa2, pa3); SBAR(); pv_tile<1, ND>(o, vb0, pa0, pa1, pa2, pa3, ACT(NT - 1)); }
    if (hi == 0) li_l[r32] = l_reg; asm volatile("s_waitcnt lgkmcnt(0)" ::: "memory");
    float rli[16];
#pragma unroll
    for (int r = 0; r < 16; ++r) rli[r] = __builtin_amdgcn_rcpf(li_l[crow(r, hi)]);
    bf16_t* Ow = cur.O + (size_t)(rb * QBLK) * PITCH + hd * 64;
    const unsigned ooff = (unsigned)(4 * hi * PITCH + r32) * 2u;
#pragma unroll
    for (int r = 0; r < 16; ++r) { const unsigned orow = (r & 3) + 8 * (r >> 2);
#pragma unroll
        for (int d0 = 0; d0 < ND; ++d0) { const float v = o[d0][r] * rli[r]; const float vn = __shfl_xor(v, 1);
            if ((r32 & 1) == 0) stg<unsigned>(Ow, ooff + (orow * PITCH + d0 * 32) * 2u, cvtpk(v, vn)); } }
    __syncthreads();
#undef VMW
#undef SLOAD_H
#undef SWRITE_HK
#undef SWRITE_HV
#undef SWRITE_H
#undef RESC
#undef KBASE
#undef ACT
#undef MASKT
#undef HALF_STEP
}
#undef KSWZ
#undef SBAR
}
constexpr int NWAVES = 8;
constexpr int N_LAUNCHES = MK_N_LAUNCHES;
constexpr int N_PHASES = 17;
constexpr int NB = 2, SEQ = 16384, DM = 2048, N_TOK = NB * SEQ, NE = 16;
constexpr int CH_TOK = 128, N_CH = N_TOK / CH_TOK;
constexpr int MAX_BLK = 272, MAX_SLOT = MAX_BLK * 256;
constexpr float ALPHA = 1.4142135623730951f, LN_EPS = 1e-5f;

constexpr size_t MiB = 1u << 20;
constexpr size_t WS_CTL = 0, CTL_ZERO_BYTES = 1 * MiB;
constexpr size_t WS_SMALL = 2 * MiB;
constexpr size_t SM_TOKE = 0, SM_TOKG = 256 * 1024, SM_SLOTOF = 512 * 1024, SM_SLOTG = 768 * 1024;
constexpr size_t SM_WGCNT = 1088 * 1024, SM_BLK = 1104 * 1024, SM_CHT = 1108 * 1024;
constexpr size_t SM_FLOC = 2 * MiB, SM_FF = 4 * MiB;
constexpr size_t WS_WQKV = 10 * MiB, WS_WAO = 34 * MiB, WS_WKVQ = 42 * MiB, WS_WBO = 66 * MiB;
constexpr size_t WS_WGU = 74 * MiB;
constexpr size_t WS_WD = 586 * MiB;
constexpr size_t WS_R1 = 842 * MiB;
constexpr size_t WS_R2 = 1114 * MiB;
constexpr size_t WS_R3 = 1370 * MiB;
constexpr size_t WS_R4 = 1498 * MiB;
constexpr size_t WS_END = 1882 * MiB;
constexpr int CW_BAR = 4096;

constexpr int RING_BYTES = 131072;
constexpr int MISC_OFF = RING_BYTES;
constexpr int TBL_OFF = RING_BYTES + 256;
constexpr int LF_OFF = RING_BYTES + 2048;
constexpr int LDS_BYTES = 147456;
static_assert(LF_OFF + 8192 <= LDS_BYTES && att::LDS_BYTES <= RING_BYTES, "LDS map");

#define GAS __attribute__((address_space(1)))
#define LAS __attribute__((address_space(3)))
typedef unsigned short bf16;
typedef unsigned v4u __attribute__((ext_vector_type(4)));
typedef float f32x4 __attribute__((ext_vector_type(4)));
typedef short bf16x8 __attribute__((ext_vector_type(8)));
typedef GAS unsigned gu32;
typedef GAS unsigned long long gu64;
#define RLX_AGENT __ATOMIC_RELAXED, __HIP_MEMORY_SCOPE_AGENT
#define LDS_WAIT() asm volatile("s_waitcnt lgkmcnt(0)" ::: "memory")
#define VM_WAIT() asm volatile("s_waitcnt vmcnt(0)" ::: "memory")
__device__ __forceinline__ unsigned long long rt() { return __builtin_amdgcn_s_memrealtime(); }
__device__ __forceinline__ unsigned f2bf(float f) { unsigned u = __builtin_bit_cast(unsigned, f); return (u + 0x7fffu + ((u >> 16) & 1u)) >> 16; }
__device__ __forceinline__ unsigned pk2(float lo, float hi) { return f2bf(lo) | (f2bf(hi) << 16); }

#define XB_TMO      128
#define XB_XCNT(j)  (256  + 64 * (j))
#define XB_XSUB(j)  (1280 + 64 * (j))
#define XB_XGEN(j)  (2304 + 64 * (j))
#define XB_TOP      3328
#define XB_TOPGEN   3392
#define XCD_BAR_WORDS 3456
#define XB_SPIN_CAP (1u << 18)

__device__ __forceinline__ unsigned xb_ld(unsigned* p)              { return __hip_atomic_load(p, __ATOMIC_RELAXED, __HIP_MEMORY_SCOPE_AGENT); }
__device__ __forceinline__ unsigned xb_add(unsigned* p, unsigned v) { return __hip_atomic_fetch_add(p, v, __ATOMIC_RELAXED, __HIP_MEMORY_SCOPE_AGENT); }
__device__ __forceinline__ unsigned xb_xcc_id() { return (unsigned)__builtin_amdgcn_s_getreg((3 << 11) | 20) & 0xFu; }
#define XB_SPIN(cond, bar) do { unsigned _sp = 0; while (cond) { __builtin_amdgcn_s_sleep(1); \
    if ((++_sp & 255u) == 0u) { if (xb_ld(&(bar)[XB_TMO])) break; if (_sp > XB_SPIN_CAP) { atomicAdd(&(bar)[XB_TMO], 1u); break; } } } } while (0)

struct XcdBarrier {
    unsigned* bar; unsigned x;
    volatile LAS unsigned* st;
};

__device__ __forceinline__ XcdBarrier xcd_barrier_post(unsigned* bar, volatile LAS unsigned* st, const bool tid0  ) {
    XcdBarrier b; b.bar = bar; b.x = xb_xcc_id(); b.st = st;
    if (tid0) (void)xb_add(&bar[XB_XCNT(b.x)], 1u);
    return b;
}
__device__ __forceinline__ void xcd_barrier_complete(unsigned* bar, unsigned x, unsigned& nloc, unsigned& nx) {
    const unsigned G = gridDim.x * gridDim.y * gridDim.z;
    unsigned sum, cnt, mine, sp = 0u;
    for (;;) {
        sum = 0u; cnt = 0u; mine = 0u;
#pragma unroll
        for (unsigned j = 0; j < 16; ++j) { const unsigned c = xb_ld(&bar[XB_XCNT(j)]); sum += c; cnt += (c > 0u) ? 1u : 0u; mine = (j == x) ? c : mine; }
        if (sum == G) break;
        __builtin_amdgcn_s_sleep(1);
        if ((++sp & 255u) == 0u) { if (xb_ld(&bar[XB_TMO])) break; if (sp > XB_SPIN_CAP) { atomicAdd(&bar[XB_TMO], 1u); break; } }
    }
    nloc = mine > 0u ? mine : 1u; nx = cnt > 0u ? cnt : 1u;
}

__device__ __forceinline__ void xcd_barrier(const XcdBarrier& b, const bool tid0  ) {
    asm volatile("s_waitcnt vmcnt(0)" ::: "memory");
    __syncthreads();
    if (tid0) {
        unsigned* bar = b.bar;
        __builtin_amdgcn_s_waitcnt(0);
        unsigned nloc = b.st[0], nx = b.st[1];
        if (nloc == 0u) { xcd_barrier_complete(bar, b.x, nloc, nx); b.st[0] = nloc; b.st[1] = nx; }
        const unsigned old = xb_add(&bar[XB_XSUB(b.x)], 1u);
        const unsigned gen = old / nloc;
        if (old + 1u == (gen + 1u) * nloc) {
            __builtin_amdgcn_fence(__ATOMIC_RELEASE, "agent");
            asm volatile("s_waitcnt vmcnt(0)" ::: "memory");
            const unsigned og = xb_add(&bar[XB_TOP], 1u);
            const unsigned tg = og / nx;
            if (og + 1u == (tg + 1u) * nx) xb_add(&bar[XB_TOPGEN], 1u);
            else XB_SPIN(xb_ld(&bar[XB_TOPGEN]) == tg, bar);
            __builtin_amdgcn_fence(__ATOMIC_ACQUIRE, "agent");
            xb_add(&bar[XB_XGEN(b.x)], 1u);
            asm volatile("s_waitcnt vmcnt(0)" ::: "memory");
        } else {
            XB_SPIN(xb_ld(&bar[XB_XGEN(b.x)]) == gen, bar);
            __builtin_amdgcn_fence(__ATOMIC_ACQUIRE, "agent");
            asm volatile("s_waitcnt vmcnt(0)" ::: "memory");
        }
    }
    __syncthreads();
}

struct Frame {
    LAS unsigned char* lds;
    volatile LAS unsigned* MISC;
    int tid, lane, wave;
    int vcu, G;
};
struct Ptrs {
    const float *x, *w_qkv, *rel_bias, *w_ao, *w_kv, *fg_w, *fg_b, *w_bq, *w_bo, *router_w, *router_b, *w_gate, *w_up, *w_down, *ln_gain, *ln_bias;
    float* out;
    bf16 *Wqkv, *Wao, *Wkvq, *Wbo, *Wgu, *Wd;
    float *S, *X;
    bf16 *HID, *XB, *QKV, *XS;
    int *tok_e, *slot_of, *wgcnt, *blk; float *tok_g, *slot_g, *cht, *floc, *ff;
};

typedef unsigned u32x2 __attribute__((ext_vector_type(2)));
__device__ __forceinline__ float wave_sum(float v) {
#pragma unroll
    for (int o = 1; o < 64; o <<= 1) v += __shfl_xor(v, o);
    return v;
}
__device__ __forceinline__ void p0_transpose_item(const float* W, int ldw, int k0, int n0, bf16* WT, int drow0, LAS float* scr, int lane) {
#pragma unroll 8
    for (int i = 0; i < 32; ++i) { const int kk = 2 * i + (lane >> 5); scr[kk * 33 + (lane & 31)] = W[(size_t)(k0 + kk) * ldw + n0 + (lane & 31)]; }
    LDS_WAIT(); asm volatile("" ::: "memory");
    const int c = lane & 7;
#pragma unroll
    for (int j = 0; j < 4; ++j) { const int n = (lane >> 3) + 8 * j; const LAS float* s = scr + (8 * c) * 33 + n;
        v4u o; o.x = pk2(s[0 * 33], s[1 * 33]); o.y = pk2(s[2 * 33], s[3 * 33]); o.z = pk2(s[4 * 33], s[5 * 33]); o.w = pk2(s[6 * 33], s[7 * 33]);
        *(GAS v4u*)(WT + (size_t)(drow0 + n) * 2048 + k0 + 8 * c) = o; }
    LDS_WAIT(); asm volatile("" ::: "memory");
}
__device__ __forceinline__ void p0_prologue(Frame& F, const Ptrs& P) {
    LAS float* scr = (LAS float*)(F.lds + F.wave * 16384);
    const int gw = F.vcu * NWAVES + F.wave, NGW = F.G * NWAVES;
    constexpr int NITEMS = 104 * 2048;
    for (int it = gw; it < NITEMS; it += NGW) {
        const int blk = it >> 11, r = it & 2047, k0 = (r >> 6) * 64, n0 = (r & 63) * 32;
        const float* src; int ldw = 2048; bf16* dst; int drow0 = n0;
        if (blk < 3) { src = P.w_qkv + blk * 2048; ldw = 6144; dst = P.Wqkv + (size_t)blk * 2048 * 2048; }
        else if (blk == 3) { src = P.w_ao; dst = P.Wao; }
        else if (blk < 6) { src = P.w_kv + (blk - 4) * 2048; ldw = 4096; dst = P.Wkvq + (size_t)(blk - 4) * 2048 * 2048; }
        else if (blk == 6) { src = P.w_bq; dst = P.Wkvq + (size_t)2 * 2048 * 2048; }
        else if (blk == 7) { src = P.w_bo; dst = P.Wbo; }
        else { const int m = blk - 8, le = m / 3, kind = m - 3 * le;
            if (kind == 2) { src = P.w_down + (size_t)le * 2048 * 2048; dst = P.Wd + (size_t)le * 2048 * 2048; }
            else { src = (kind == 0 ? P.w_gate : P.w_up) + (size_t)le * 2048 * 2048; dst = P.Wgu + (size_t)le * 4096 * 2048; drow0 = 256 * (n0 >> 7) + (n0 & 127) + 128 * kind; } }
        p0_transpose_item(src, ldw, k0, n0, dst, drow0, scr, F.lane);
    }
    const size_t n8 = (size_t)N_TOK * DM / 8;
    for (size_t i = (size_t)blockIdx.x * 512 + F.tid; i < n8; i += (size_t)F.G * 512) {
        const f32x4 a = ((const GAS f32x4*)P.x)[2 * i], b = ((const GAS f32x4*)P.x)[2 * i + 1];
        v4u o; o.x = pk2(a.x, a.y); o.y = pk2(a.z, a.w); o.z = pk2(b.x, b.y); o.w = pk2(b.z, b.w);
        ((GAS v4u*)P.XB)[i] = o; }
}
__device__ __forceinline__ void load_wT(Frame& F, const float* W) {
    LAS float* wT = (LAS float*)F.lds;
    for (int i = F.tid; i < 2048 * 16; i += NWAVES * 64) wT[(i & 15) * 2048 + (i >> 4)] = W[i];
}
#define MEMFENCE() asm volatile("" ::: "memory")
template <class T> __device__ __forceinline__ T ldg(const void* base, unsigned boff) { return *(const GAS T*)((const GAS char*)base + boff); }
template <class T> __device__ __forceinline__ void stg(void* base, unsigned boff, T v) { *(GAS T*)((GAS char*)base + boff) = v; }
__device__ __forceinline__ void ln2rows(f32x4 (&v0)[8], f32x4 (&v1)[8], const float* gain, const float* bias, int lane) {
    float s0 = 0.f, s1 = 0.f;
#pragma unroll
    for (int j = 0; j < 8; ++j) { s0 += (v0[j].x + v0[j].y) + (v0[j].z + v0[j].w); s1 += (v1[j].x + v1[j].y) + (v1[j].z + v1[j].w); }
    const float m0 = wave_sum(s0) * (1.f / DM), m1 = wave_sum(s1) * (1.f / DM);
    float q0 = 0.f, q1 = 0.f;
#pragma unroll
    for (int j = 0; j < 8; ++j) { v0[j] = v0[j] - m0; v1[j] = v1[j] - m1;
        q0 += (v0[j].x * v0[j].x + v0[j].y * v0[j].y) + (v0[j].z * v0[j].z + v0[j].w * v0[j].w);
        q1 += (v1[j].x * v1[j].x + v1[j].y * v1[j].y) + (v1[j].z * v1[j].z + v1[j].w * v1[j].w); }
    const float r0 = 1.f / sqrtf(wave_sum(q0) * (1.f / DM) + LN_EPS), r1 = 1.f / sqrtf(wave_sum(q1) * (1.f / DM) + LN_EPS);
    MEMFENCE();
#pragma unroll
    for (int j = 0; j < 8; ++j) { const f32x4 g = ldg<f32x4>(gain, (unsigned)(64 * j + lane) * 16u), b = ldg<f32x4>(bias, (unsigned)(64 * j + lane) * 16u); v0[j] = v0[j] * r0 * g + b; v1[j] = v1[j] * r1 * g + b; if ((j & 3) == 3) MEMFENCE(); }
}
__device__ __forceinline__ float dot16x2(Frame& F, const f32x4 (&y0)[8], const f32x4 (&y1)[8]) {
    const LAS f32x4* wp = (const LAS f32x4*)F.lds + F.lane;
    float mine = 0.f;
#pragma unroll 1
    for (int e = 0; e < 16; ++e, wp += 512) {
        float a0 = 0.f, a1 = 0.f;
#pragma unroll
        for (int j = 0; j < 8; ++j) { const f32x4 w = wp[64 * j];
            a0 += (y0[j].x * w.x + y0[j].y * w.y) + (y0[j].z * w.z + y0[j].w * w.w);
            a1 += (y1[j].x * w.x + y1[j].y * w.y) + (y1[j].z * w.z + y1[j].w * w.w); }
        a0 = wave_sum(a0); a1 = wave_sum(a1);
        mine = (F.lane == e) ? a0 : ((F.lane == 16 + e) ? a1 : mine);
    }
    return mine;
}
__device__ __forceinline__ void store_row_bf16(bf16* dst  , const f32x4 (&v)[8], int lane) {
#pragma unroll
    for (int j = 0; j < 8; ++j) stg<unsigned long long>(dst, (unsigned)(64 * j + lane) * 8u, (unsigned long long)pk2(v[j].x, v[j].y) | ((unsigned long long)pk2(v[j].z, v[j].w) << 32));
}
__device__ __forceinline__ void store_row_f32(float* dst  , const f32x4 (&v)[8], int lane) {
#pragma unroll
    for (int j = 0; j < 8; ++j) stg<f32x4>(dst, (unsigned)(64 * j + lane) * 16u, v[j]);
}
__device__ __forceinline__ void route16(const float (&lg)[16], const float* rb, int& e0, int& e1, float& g0, float& g1) {
    float l[16]; float m = -__builtin_inff();
#pragma unroll
    for (int e = 0; e < 16; ++e) { l[e] = lg[e] + rb[e]; m = fmaxf(m, l[e]); }
    float p[16];
#pragma unroll
    for (int e = 0; e < 16; ++e) p[e] = __expf(l[e] - m);
    int bg = 0; float bs = -1.f;
#pragma unroll
    for (int g = 0; g < 4; ++g) { const float a0 = p[4 * g], a1 = p[4 * g + 1], a2 = p[4 * g + 2], a3 = p[4 * g + 3];
        const float h1 = fmaxf(a0, a1), l1 = fminf(a0, a1), h2 = fmaxf(a2, a3), l2 = fminf(a2, a3);
        const float top = fmaxf(h1, h2), sec = fmaxf(fminf(h1, h2), h1 >= h2 ? l1 : l2), sc = top + sec;
        if (sc > bs) { bs = sc; bg = g; } }
    float a[4];
#pragma unroll
    for (int i = 0; i < 4; ++i) a[i] = bg == 0 ? p[i] : bg == 1 ? p[4 + i] : bg == 2 ? p[8 + i] : p[12 + i];
    float va = a[0], vb = -1.f; int ia = 0, ib = 0;
#pragma unroll
    for (int i = 1; i < 4; ++i) { if (a[i] > va) { vb = va; ib = ia; va = a[i]; ia = i; } else if (a[i] > vb) { vb = a[i]; ib = i; } }
    const float inv = 1.f / (va + vb);
    e0 = 4 * bg + ia; e1 = 4 * bg + ib; g0 = va * inv; g1 = vb * inv;
}
__device__ __forceinline__ void ln1_route_phase(Frame& F, const Ptrs& P, int layer) {
    load_wT(F, P.router_w);
    LAS int* hist = (LAS int*)(F.lds + TBL_OFF);
    const float* gain = P.ln_gain + (size_t)(layer * 2 + 0) * DM; const float* bias = P.ln_bias + (size_t)(layer * 2 + 0) * DM;
    float rb[16];
#pragma unroll
    for (int e = 0; e < 16; ++e) rb[e] = P.router_b[e];
    for (int ch = F.vcu; ch < N_CH; ch += F.G) {
        if (F.tid < 16) hist[F.tid] = 0;
        __syncthreads();
#pragma unroll 1
        for (int pr = 0; pr < 8; ++pr) {
            const int t0 = ch * CH_TOK + F.wave * 16 + 2 * pr;
            int ln = F.lane; asm volatile("" : "+v"(ln));
            f32x4 v0[8], v1[8];
            { const float* p0 = P.S + (size_t)t0 * DM; const float* p1 = p0 + DM;
              MEMFENCE();
#pragma unroll
              for (int j = 0; j < 8; ++j) { v0[j] = ldg<f32x4>(p0, (unsigned)(64 * j + ln) * 16u); v1[j] = ldg<f32x4>(p1, (unsigned)(64 * j + ln) * 16u); if ((j & 3) == 3) MEMFENCE(); } }
            ln2rows(v0, v1, gain, bias, ln);
            store_row_f32(P.X + (size_t)t0 * DM, v0, ln); store_row_f32(P.X + (size_t)(t0 + 1) * DM, v1, ln);
            store_row_bf16(P.XB + (size_t)t0 * DM, v0, ln); store_row_bf16(P.XB + (size_t)(t0 + 1) * DM, v1, ln);
            const float mine = dot16x2(F, v0, v1);
            float lg[16];
#pragma unroll
            for (int e = 0; e < 16; ++e) { const float s0 = __uint_as_float(__builtin_amdgcn_readlane(__float_as_uint(mine), e)), s1 = __uint_as_float(__builtin_amdgcn_readlane(__float_as_uint(mine), 16 + e)); lg[e] = F.lane == 1 ? s1 : s0; }
            int e0, e1; float g0, g1;
            route16(lg, rb, e0, e1, g0, g1);
            if (F.lane < 2) { const int t = t0 + F.lane; P.tok_e[2 * t] = e0; P.tok_e[2 * t + 1] = e1; P.tok_g[2 * t] = g0; P.tok_g[2 * t + 1] = g1;
                __hip_atomic_fetch_add(&hist[e0], 1, __ATOMIC_RELAXED, __HIP_MEMORY_SCOPE_WORKGROUP); __hip_atomic_fetch_add(&hist[e1], 1, __ATOMIC_RELAXED, __HIP_MEMORY_SCOPE_WORKGROUP); }
        }
        __syncthreads();
        if (F.tid < 16) P.wgcnt[ch * 16 + F.tid] = hist[F.tid];
        __syncthreads();
    }
}
__device__ __forceinline__ void scatter_phase(Frame& F, const Ptrs& P) {
    LAS int* cnt = (LAS int*)F.lds;
    LAS int* psum = cnt + 4096;
    LAS int* tot = psum + 512; LAS int* pst = tot + 16; LAS int* bas = pst + 16;
    LAS int* elist = bas + 16; LAS int* slist = elist + 256;
    for (int ch = F.vcu; ch < N_CH; ch += F.G) {
        for (int i = F.tid; i < N_CH * 16; i += NWAVES * 64) cnt[i] = P.wgcnt[i];
        __syncthreads();
        { const int p = F.tid >> 4, e = F.tid & 15; int s = 0;
#pragma unroll
          for (int c = 0; c < 8; ++c) s += cnt[(8 * p + c) * 16 + e];
          psum[p * 16 + e] = s; }
        __syncthreads();
        if (F.tid < 16) { const int e = F.tid, mp = ch >> 3; int run = 0, mb = 0;
            for (int p = 0; p < 32; ++p) { if (p == mp) mb = run; run += psum[p * 16 + e]; }
            for (int c = 8 * mp; c < ch; ++c) mb += cnt[c * 16 + e];
            tot[e] = run; bas[e] = mb; }
        __syncthreads();
        if (F.tid == 0) { int ps = 0;
            for (int e = 0; e < 16; ++e) { pst[e] = ps; const int pd = (tot[e] + 255) & ~255;
                if (ch == 0) for (int bq = ps >> 8; bq < ((ps + pd) >> 8); ++bq) P.blk[16 + bq] = e;
                ps += pd; }
            if (ch == 0) P.blk[0] = ps >> 8; }
        __syncthreads();
        if (F.tid < 256) elist[F.tid] = P.tok_e[2 * (ch * CH_TOK) + F.tid];
        __syncthreads();
        if (F.tid < 256) { const int e = elist[F.tid]; int rank = 0;
            for (int q = 0; q < F.tid; ++q) rank += (elist[q] == e) ? 1 : 0;
            const int slot = pst[e] + bas[e] + rank; slist[F.tid] = slot;
            P.slot_of[2 * (ch * CH_TOK) + F.tid] = slot; P.slot_g[slot] = P.tok_g[2 * (ch * CH_TOK) + F.tid]; }
        __syncthreads();
        for (int q = 0; q < 32; ++q) { const int pi = F.wave * 32 + q, tok = ch * CH_TOK + (pi >> 1), slot = slist[pi];
            const GAS v4u* src = (const GAS v4u*)(P.XB + (size_t)tok * DM) + F.lane; GAS v4u* dst = (GAS v4u*)(P.XS + (size_t)slot * DM) + F.lane;
            const v4u c0 = src[0], c1 = src[64], c2 = src[128], c3 = src[192]; dst[0] = c0; dst[64] = c1; dst[128] = c2; dst[192] = c3; }
        if (ch < 16) { const int e = ch, lo = pst[e] + tot[e], hi = pst[e] + ((tot[e] + 255) & ~255); const v4u z = {0u, 0u, 0u, 0u};
            for (int s = lo + F.wave; s < hi; s += NWAVES) { GAS v4u* dst = (GAS v4u*)(P.XS + (size_t)s * DM) + F.lane; dst[0] = z; dst[64] = z; dst[128] = z; dst[192] = z; if (F.lane == 0) P.slot_g[s] = 0.f; } }
        __syncthreads();
    }
}
__device__ __forceinline__ void combine_ln2_phase(Frame& F, const Ptrs& P, int layer, float* out_f) {
    const bool fg = layer == 0;
    if (fg) load_wT(F, P.fg_w);
    LAS float* lf = (LAS float*)(F.lds + LF_OFF);
    const float* gain = P.ln_gain + (size_t)(layer * 2 + 1) * DM; const float* bias = P.ln_bias + (size_t)(layer * 2 + 1) * DM;
    float fb[16];
#pragma unroll
    for (int e = 0; e < 16; ++e) fb[e] = P.fg_b[e];
    __syncthreads();
    for (int ch = F.vcu; ch < N_CH; ch += F.G) {
#pragma unroll 1
        for (int pr = 0; pr < 8; ++pr) {
            const int r0 = F.wave * 16 + 2 * pr, t0 = ch * CH_TOK + r0;
            int ln = F.lane; asm volatile("" : "+v"(ln));
            f32x4 v0[8], v1[8];
            { const float* p0 = P.X + (size_t)t0 * DM; const float* p1 = p0 + DM;
              const int s00 = __builtin_amdgcn_readfirstlane(P.slot_of[2 * t0]), s01 = __builtin_amdgcn_readfirstlane(P.slot_of[2 * t0 + 1]);
              const int s10 = __builtin_amdgcn_readfirstlane(P.slot_of[2 * t0 + 2]), s11 = __builtin_amdgcn_readfirstlane(P.slot_of[2 * t0 + 3]);
              const bf16* y00 = P.XS + (size_t)s00 * DM; const bf16* y01 = P.XS + (size_t)s01 * DM; const bf16* y10 = P.XS + (size_t)s10 * DM; const bf16* y11 = P.XS + (size_t)s11 * DM;
              MEMFENCE();
#pragma unroll
              for (int j = 0; j < 8; ++j) { const unsigned ix = (unsigned)(64 * j + ln);
                  const f32x4 x0 = ldg<f32x4>(p0, ix * 16u), x1 = ldg<f32x4>(p1, ix * 16u); const u32x2 a = ldg<u32x2>(y00, ix * 8u), c = ldg<u32x2>(y01, ix * 8u), d = ldg<u32x2>(y10, ix * 8u), e = ldg<u32x2>(y11, ix * 8u);
                  v0[j].x = x0.x * ALPHA + (__uint_as_float(a.x << 16) + __uint_as_float(c.x << 16)); v0[j].y = x0.y * ALPHA + (__uint_as_float(a.x & 0xffff0000u) + __uint_as_float(c.x & 0xffff0000u));
                  v0[j].z = x0.z * ALPHA + (__uint_as_float(a.y << 16) + __uint_as_float(c.y << 16)); v0[j].w = x0.w * ALPHA + (__uint_as_float(a.y & 0xffff0000u) + __uint_as_float(c.y & 0xffff0000u));
                  v1[j].x = x1.x * ALPHA + (__uint_as_float(d.x << 16) + __uint_as_float(e.x << 16)); v1[j].y = x1.y * ALPHA + (__uint_as_float(d.x & 0xffff0000u) + __uint_as_float(e.x & 0xffff0000u));
                  v1[j].z = x1.z * ALPHA + (__uint_as_float(d.y << 16) + __uint_as_float(e.y << 16)); v1[j].w = x1.w * ALPHA + (__uint_as_float(d.y & 0xffff0000u) + __uint_as_float(e.y & 0xffff0000u));
                  if (j & 1) MEMFENCE(); } }
            ln2rows(v0, v1, gain, bias, ln);
            store_row_f32(out_f + (size_t)t0 * DM, v0, ln); store_row_f32(out_f + (size_t)(t0 + 1) * DM, v1, ln);
            if (fg) {
                store_row_bf16(P.XB + (size_t)t0 * DM, v0, ln); store_row_bf16(P.XB + (size_t)(t0 + 1) * DM, v1, ln);
                float z = dot16x2(F, v0, v1);
#pragma unroll
                for (int e = 0; e < 16; ++e) z += (F.lane & 15) == e ? fb[e] : 0.f;
                const float az = fabsf(z), lsg = fminf(z, 0.f) - log1pf(__expf(-az));
                if (F.lane < 32) lf[(r0 + (F.lane >> 4)) * 16 + (F.lane & 15)] = lsg;
            }
        }
        if (fg) {
            __syncthreads();
            if (F.tid < 16) { float run = 0.f; for (int i = 0; i < CH_TOK; ++i) { run += lf[i * 16 + F.tid]; lf[i * 16 + F.tid] = run; } P.cht[ch * 16 + F.tid] = run; }
            __syncthreads();
            for (int i = F.tid; i < CH_TOK * 16; i += NWAVES * 64) P.floc[(size_t)ch * CH_TOK * 16 + i] = lf[i];
            __syncthreads();
        }
    }
}
__device__ __forceinline__ void f_finalize(Frame& F, const Ptrs& P) {
    LAS float* bas = (LAS float*)(F.lds + TBL_OFF);
    for (int ch = F.vcu; ch < N_CH; ch += F.G) {
        const int b = ch >> 7, ci = ch & 127;
        if (F.tid < 16) { float s = 0.f; for (int c = b * 128; c < ch; ++c) s += P.cht[c * 16 + F.tid]; bas[F.tid] = s; }
        __syncthreads();
        for (int i = F.tid; i < CH_TOK * 16; i += NWAVES * 64) { const int h = i >> 7, s = i & 127;
            P.ff[(size_t)(b * 16 + h) * SEQ + ci * CH_TOK + s] = bas[h] + P.floc[(size_t)ch * CH_TOK * 16 + s * 16 + h]; }
        __syncthreads();
    }
}
__device__ __forceinline__ int load_blk_table(Frame& F, const Ptrs& P) {
    LAS int* tb = (LAS int*)(F.lds + TBL_OFF);
    if (F.tid < 16 + MAX_BLK) tb[F.tid] = P.blk[F.tid];
    __syncthreads();
    int nblk = __builtin_amdgcn_readfirstlane(tb[0]);
    return nblk > MAX_BLK ? MAX_BLK : nblk;
}

struct Args { const float* in[16]; float* out; unsigned char* ws; int ph_lo, ph_hi, li, pad; };
__device__ __forceinline__ void refresh(Frame& F) {
    int l; asm volatile("v_mbcnt_lo_u32_b32 %0, -1, 0\n\tv_mbcnt_hi_u32_b32 %0, -1, %0" : "=v"(l));
    F.lane = l; F.tid = F.wave * 64 + l;
}
__device__ __forceinline__ Ptrs mk_ptrs() {
    typedef __attribute__((address_space(4))) const Args* KA;
    KA ap = (KA)__builtin_amdgcn_kernarg_segment_ptr();
    asm volatile("" : "+s"(ap));
    Ptrs P; unsigned char* ws = ap->ws;
    P.x = ap->in[0]; P.w_qkv = ap->in[1]; P.rel_bias = ap->in[2]; P.w_ao = ap->in[3]; P.w_kv = ap->in[4]; P.fg_w = ap->in[5]; P.fg_b = ap->in[6]; P.w_bq = ap->in[7];
    P.w_bo = ap->in[8]; P.router_w = ap->in[9]; P.router_b = ap->in[10]; P.w_gate = ap->in[11]; P.w_up = ap->in[12]; P.w_down = ap->in[13]; P.ln_gain = ap->in[14]; P.ln_bias = ap->in[15];
    P.out = ap->out;
    P.Wqkv = (bf16*)(ws + WS_WQKV); P.Wao = (bf16*)(ws + WS_WAO); P.Wkvq = (bf16*)(ws + WS_WKVQ); P.Wbo = (bf16*)(ws + WS_WBO); P.Wgu = (bf16*)(ws + WS_WGU); P.Wd = (bf16*)(ws + WS_WD);
    P.S = (float*)(ws + WS_R1); P.HID = (bf16*)(ws + WS_R1); P.X = (float*)(ws + WS_R2); P.XB = (bf16*)(ws + WS_R3); P.QKV = (bf16*)(ws + WS_R4); P.XS = (bf16*)(ws + WS_R4);
    { unsigned char* sm = ws + WS_SMALL; P.tok_e = (int*)(sm + SM_TOKE); P.tok_g = (float*)(sm + SM_TOKG); P.slot_of = (int*)(sm + SM_SLOTOF); P.slot_g = (float*)(sm + SM_SLOTG);
      P.wgcnt = (int*)(sm + SM_WGCNT); P.blk = (int*)(sm + SM_BLK); P.cht = (float*)(sm + SM_CHT); P.floc = (float*)(sm + SM_FLOC); P.ff = (float*)(sm + SM_FF); }
    return P;
}
__global__ void __launch_bounds__(NWAVES * 64, 2) yoco_fwd(Args args) {
    extern __shared__ __attribute__((aligned(16))) unsigned char lds[];
    Frame F;
    F.lds = (LAS unsigned char*)lds;
    F.MISC = (volatile LAS unsigned*)(F.lds + MISC_OFF);
    F.tid = threadIdx.x; F.lane = F.tid & 63; F.wave = __builtin_amdgcn_readfirstlane(F.tid >> 6);
    F.G = gridDim.x; { const int bx = blockIdx.x; F.vcu = (F.G % 8 == 0) ? (bx % 8) * (F.G / 8) + bx / 8 : bx; }
    for (int u = F.tid; u < 64; u += NWAVES * 64) ((LAS unsigned*)(F.lds + MISC_OFF))[u] = 0u;
    __syncthreads();
    unsigned* const barw = (unsigned*)(args.ws + WS_CTL) + CW_BAR;
    XcdBarrier bar; bar.bar = barw; bar.x = 0; bar.st = nullptr;
    if (N_LAUNCHES == 1) bar = xcd_barrier_post(barw, F.MISC + 8, F.tid == 0);
#define GRID_BAR() do { if (N_LAUNCHES == 1) xcd_barrier(bar, F.tid == 0); } while (0)
    const int lo = args.ph_lo, hi = args.ph_hi;
#ifndef PH_MASK
#define PH_MASK 0x1ffff
#endif
#define IN(k) ((((PH_MASK) >> (k)) & 1) && lo <= (k) && (k) < hi)
#define BOTH(k) (IN(k) && IN((k) + 1))
    constexpr size_t TSTRIDE = (size_t)N_TOK * DM;
    LAS unsigned char* ring = F.lds;

    if (IN(0)) { asm volatile("; PHASE_0" ::: "memory"); refresh(F); const Ptrs P = mk_ptrs(); p0_prologue(F, P); if (BOTH(0)) GRID_BAR(); }

    if (IN(1)) { asm volatile("; PHASE_1" ::: "memory"); refresh(F); const Ptrs P = mk_ptrs();
        pg8::Gemm g{P.XB, P.Wqkv, N_TOK, 3 * DM, DM}; pg8::StaticOrder S; S.init(N_TOK, 3 * DM, F.G, (int)blockIdx.x);
        pg8::EpiBf16<0> E{P.QKV, DM, nullptr, DM, TSTRIDE, 1.0f};
        pg8::gemm_phase<pg8::EpiBf16<0>, pg8::StaticOrder, true, true>(ring, g, S, E, F.tid);
        if (BOTH(1)) GRID_BAR();
    }
    if (IN(2)) { asm volatile("; PHASE_2" ::: "memory"); refresh(F); const Ptrs P = mk_ptrs();
        for (int L = F.vcu; L < NB * 16 * 128; L += F.G) {
            const int c2 = L & 127, hp = (L >> 7) & 15, b = L >> 11;
            att::Blk k; k.P0 = c2 * 128; k.j_lo = 0; k.F = nullptr; k.tab = P.rel_bias + (size_t)(hp * 2) * 257;
            bf16* q = P.QKV + ((size_t)b * SEQ + k.P0) * DM + hp * 128;
            k.Q = q; k.O = q; k.K = P.QKV + TSTRIDE + (size_t)b * SEQ * DM + hp * 128; k.V = P.QKV + 2 * TSTRIDE + (size_t)b * SEQ * DM + hp * 128;
            att::attn_block<1>(k, (char*)lds, F.tid);
        }
        if (BOTH(2)) GRID_BAR();
    }
    if (IN(3)) { asm volatile("; PHASE_3" ::: "memory"); refresh(F); const Ptrs P = mk_ptrs();
        pg8::Gemm g{P.QKV, P.Wao, N_TOK, DM, DM}; pg8::StaticOrder S; S.init(N_TOK, DM, F.G, (int)blockIdx.x);
        pg8::EpiResF32 E{P.x, P.S, ALPHA};
        pg8::gemm_phase<pg8::EpiResF32, pg8::StaticOrder, true, true>(ring, g, S, E, F.tid);
        if (BOTH(3)) GRID_BAR();
    }
    if (IN(4)) { asm volatile("; PHASE_4" ::: "memory"); refresh(F); const Ptrs P = mk_ptrs(); ln1_route_phase(F, P, 0); if (BOTH(4)) GRID_BAR(); }
    if (IN(5)) { asm volatile("; PHASE_5" ::: "memory"); refresh(F); const Ptrs P = mk_ptrs(); scatter_phase(F, P); if (BOTH(5)) GRID_BAR(); }
    if (IN(6)) { asm volatile("; PHASE_6" ::: "memory"); refresh(F); const Ptrs P = mk_ptrs();
        const int nblk = load_blk_table(F, P);
        pg8::Gemm g{P.XS, P.Wgu, MAX_SLOT, 4096, DM}; pg8::MoeOrder S; S.init(nblk, 4096, F.G, (int)blockIdx.x, (const LAS int*)(F.lds + TBL_OFF) + 16, (size_t)4096 * 2048 * 2);
        pg8::EpiSwiGLU E{P.HID};
        pg8::gemm_phase<pg8::EpiSwiGLU, pg8::MoeOrder, true, true>(ring, g, S, E, F.tid);
        if (BOTH(6)) GRID_BAR();
    }
    if (IN(7)) { asm volatile("; PHASE_7" ::: "memory"); refresh(F); const Ptrs P = mk_ptrs();
        const int nblk = load_blk_table(F, P);
        pg8::Gemm g{P.HID, P.Wd, MAX_SLOT, DM, DM}; pg8::MoeOrder S; S.init(nblk, DM, F.G, (int)blockIdx.x, (const LAS int*)(F.lds + TBL_OFF) + 16, (size_t)2048 * 2048 * 2);
        pg8::EpiGateBf16 E{P.XS, P.slot_g};
        pg8::gemm_phase<pg8::EpiGateBf16, pg8::MoeOrder, true, true>(ring, g, S, E, F.tid);
        if (BOTH(7)) GRID_BAR();
    }
    if (IN(8)) { asm volatile("; PHASE_8" ::: "memory"); refresh(F); const Ptrs P = mk_ptrs(); combine_ln2_phase(F, P, 0, P.X); if (BOTH(8)) GRID_BAR(); }
    if (IN(9)) { asm volatile("; PHASE_9" ::: "memory"); refresh(F); const Ptrs P = mk_ptrs();
        f_finalize(F, P);
        pg8::Gemm g{P.XB, P.Wkvq, N_TOK, 3 * DM, DM}; pg8::StaticOrder S; S.init(N_TOK, 3 * DM, F.G, (int)blockIdx.x);
        pg8::EpiBf16<0> E{P.QKV, DM, nullptr, DM, TSTRIDE, 1.0f};
        pg8::gemm_phase<pg8::EpiBf16<0>, pg8::StaticOrder, true, true>(ring, g, S, E, F.tid);
        if (BOTH(9)) GRID_BAR();
    }
    if (IN(10)) { asm volatile("; PHASE_10" ::: "memory"); refresh(F); const Ptrs P = mk_ptrs();
        for (int kk = 0;; ++kk) {
            const int it = F.vcu + F.G * (kk >> 1); if (it >= NB * 16 * 32) break;
            const int bh = it >> 5, y = it & 31, pass = kk & 1, qb = pass ? 63 - y : y, b = bh >> 4, h = bh & 15;
            att::Blk k; k.P0 = qb * 256; k.j_lo = 0; k.tab = nullptr; k.F = P.ff + (size_t)bh * SEQ;
            bf16* q = P.QKV + 2 * TSTRIDE + ((size_t)b * SEQ + k.P0) * DM + h * 128;
            k.Q = q; k.O = q; k.K = P.QKV + (size_t)b * SEQ * DM + h * 128; k.V = P.QKV + TSTRIDE + (size_t)b * SEQ * DM + h * 128;
            att::attn_block<0>(k, (char*)lds, F.tid);
        }
        if (BOTH(10)) GRID_BAR();
    }
    if (IN(11)) { asm volatile("; PHASE_11" ::: "memory"); refresh(F); const Ptrs P = mk_ptrs();
        pg8::Gemm g{P.QKV + 2 * TSTRIDE, P.Wbo, N_TOK, DM, DM}; pg8::StaticOrder S; S.init(N_TOK, DM, F.G, (int)blockIdx.x);
        pg8::EpiResF32 E{P.X, P.S, ALPHA};
        pg8::gemm_phase<pg8::EpiResF32, pg8::StaticOrder, true, true>(ring, g, S, E, F.tid);
        if (BOTH(11)) GRID_BAR();
    }
    if (IN(12)) { asm volatile("; PHASE_12" ::: "memory"); refresh(F); const Ptrs P = mk_ptrs(); ln1_route_phase(F, P, 1); if (BOTH(12)) GRID_BAR(); }
    if (IN(13)) { asm volatile("; PHASE_13" ::: "memory"); refresh(F); const Ptrs P = mk_ptrs(); scatter_phase(F, P); if (BOTH(13)) GRID_BAR(); }
    if (IN(14)) { asm volatile("; PHASE_14" ::: "memory"); refresh(F); const Ptrs P = mk_ptrs();
        const int nblk = load_blk_table(F, P);
        pg8::Gemm g{P.XS, P.Wgu + (size_t)16 * 4096 * 2048, MAX_SLOT, 4096, DM}; pg8::MoeOrder S; S.init(nblk, 4096, F.G, (int)blockIdx.x, (const LAS int*)(F.lds + TBL_OFF) + 16, (size_t)4096 * 2048 * 2);
        pg8::EpiSwiGLU E{P.HID};
        pg8::gemm_phase<pg8::EpiSwiGLU, pg8::MoeOrder, true, true>(ring, g, S, E, F.tid);
        if (BOTH(14)) GRID_BAR();
    }
    if (IN(15)) { asm volatile("; PHASE_15" ::: "memory"); refresh(F); const Ptrs P = mk_ptrs();
        const int nblk = load_blk_table(F, P);
        pg8::Gemm g{P.HID, P.Wd + (size_t)16 * 2048 * 2048, MAX_SLOT, DM, DM}; pg8::MoeOrder S; S.init(nblk, DM, F.G, (int)blockIdx.x, (const LAS int*)(F.lds + TBL_OFF) + 16, (size_t)2048 * 2048 * 2);
        pg8::EpiGateBf16 E{P.XS, P.slot_g};
        pg8::gemm_phase<pg8::EpiGateBf16, pg8::MoeOrder, true, true>(ring, g, S, E, F.tid);
        if (BOTH(15)) GRID_BAR();
    }
    if (IN(16)) { asm volatile("; PHASE_16" ::: "memory"); refresh(F); const Ptrs P = mk_ptrs(); combine_ln2_phase(F, P, 1, P.out); }
#undef IN
#undef BOTH
#undef GRID_BAR
}

extern "C" void kernel_launch(void* const* d_in, const int* in_sizes, int n_in, void* d_out, int out_size, void* d_ws, size_t ws_size, hipStream_t stream) {
    static int grid = 0;
    if (grid == 0) {
        if (n_in != 16 || in_sizes[0] != N_TOK * DM || out_size != N_TOK * DM || ws_size < WS_END) { fprintf(stderr, "kernel_launch: shape mismatch (n_in %d, in0 %d, out %d, ws %zu < %zu); nothing launched\n", n_in, n_in > 0 ? in_sizes[0] : -1, out_size, ws_size, (size_t)WS_END); grid = -1; return; }
        int dev = 0, cus = 0, per_cu = 0;
        if (hipGetDevice(&dev) != hipSuccess || hipDeviceGetAttribute(&cus, hipDeviceAttributeMultiprocessorCount, dev) != hipSuccess) { fprintf(stderr, "kernel_launch: device query failed\n"); grid = -1; return; }
        if (hipFuncSetAttribute((const void*)yoco_fwd, hipFuncAttributeMaxDynamicSharedMemorySize, LDS_BYTES) != hipSuccess) { fprintf(stderr, "kernel_launch: hipFuncSetAttribute failed\n"); grid = -1; return; }
        if (hipOccupancyMaxActiveBlocksPerMultiprocessor(&per_cu, (const void*)yoco_fwd, NWAVES * 64, LDS_BYTES) != hipSuccess || per_cu < 1)
            fprintf(stderr, "kernel_launch: note: occupancy query reports %d workgroups per CU\n", per_cu);
        (void)hipGetLastError();
        grid = cus;
    }
    if (grid < 0) return;
    if (hipMemsetAsync((char*)d_ws + WS_CTL, 0, CTL_ZERO_BYTES, stream) != hipSuccess) { fprintf(stderr, "kernel_launch: memset failed\n"); return; }
    Args a{};
    for (int i = 0; i < 16; ++i) a.in[i] = (const float*)d_in[i];
    a.out = (float*)d_out; a.ws = (unsigned char*)d_ws;
    for (int li = 0; li < N_LAUNCHES; ++li) {
        a.ph_lo = (N_LAUNCHES == 1) ? 0 : li; a.ph_hi = (N_LAUNCHES == 1) ? N_PHASES : li + 1; a.li = li; a.pad = 0;
        hipLaunchKernelGGL(yoco_fwd, dim3(grid), dim3(NWAVES * 64), LDS_BYTES, stream, a);
        const hipError_t le = hipPeekAtLastError();
        if (le != hipSuccess) { fprintf(stderr, "kernel_launch: launch %d failed: %s\n", li, hipGetErrorName(le)); break; }
    }
}
```

```cpp
#include <hip/hip_runtime.h>
#include <cstdio>
#include <cstdint>
#ifndef MK_N_LAUNCHES
#define MK_N_LAUNCHES 1
#endif
namespace pg8 {
#define PG8_LAS __attribute__((address_space(3)))
typedef unsigned short bf16_t;
typedef short bf16x8 __attribute__((ext_vector_type(8)));
typedef float f32x4 __attribute__((ext_vector_type(4)));
typedef unsigned u32x4 __attribute__((ext_vector_type(4)));
constexpr int BM = 256, BK = 64, HALF = 128, HTB = HALF * BK * 2  , STAGE_BYTES = 8 * HTB, NXCD = 8, WGM = 8;

__host__ __device__ __forceinline__ int lds_byte(int r, int c) { const int st = (r >> 4) * 2 + (c >> 5), rr = r & 15, cc = c & 31, ob = rr * 64 + cc * 2; return st * 1024 + (ob ^ (((ob >> 9) & 1) << 5)); }
__host__ __device__ __forceinline__ void stage_rc(int b, int& R, int& C) { const int st = b / 1024, sb = b % 1024, swz = sb ^ (((sb >> 9) & 1) << 5); R = (st >> 1) * 16 + swz / 64; C = (st & 1) * 32 + (swz % 64) / 2; }
__host__ __device__ __forceinline__ int perm32(int rho) { const int n = rho >> 4, i = rho & 15; return 8 * (i >> 2) + 4 * n + (i & 3); }

struct Unit { int pm, pn, ex; size_t boff; };
struct Gemm { const bf16_t* A; const bf16_t* Bt; int M, N, K; };

struct StaticOrder {
    int nM, nN, nwg, G, c;
    __host__ __device__ void init(int M, int N, int G_, int c_) { nM = M / BM; nN = N / BM; nwg = nM * nN; G = G_; c = c_; }
    __host__ __device__ bool next(int i, Unit& u) const {
        const long L = (long)i * G + c; if (L >= nwg) return false;
        int wgid = (int)L; { const int q = nwg / NXCD, r = nwg % NXCD, xcd = wgid % NXCD, off = wgid / NXCD; wgid = (xcd < r ? xcd * (q + 1) : r * (q + 1) + (xcd - r) * q) + off; }
        const int nig = WGM * nN, gid = wgid / nig, fm = gid * WGM, gsz = (nM - fm) < WGM ? (nM - fm) : WGM;
        u.pm = fm + ((wgid % nig) % gsz); u.pn = (wgid % nig) / gsz; u.ex = 0; u.boff = 0; return true;
    }
    __device__ __forceinline__ void a_ready(const Unit&) const {}
    __device__ __forceinline__ void done(const Unit&) const {}
};

__device__ __forceinline__ unsigned cvt_pk_bf16(float lo, float hi) { unsigned r; asm volatile("v_cvt_pk_bf16_f32 %0, %1, %2" : "=v"(r) : "v"(lo), "v"(hi)); return r; }
typedef float f32x2 __attribute__((ext_vector_type(2)));
__device__ __forceinline__ f32x2 gelu_pk(f32x2 v) {
    const f32x2 av = __builtin_elementwise_abs(v), d = av * 0.2316418882f + 1.0f;
    f32x2 t; t.x = __builtin_amdgcn_rcpf(d.x); t.y = __builtin_amdgcn_rcpf(d.y);
    f32x2 q = t * 0.5307027145f + (-0.7265760135f); q = q * t + 0.7107068705f; q = q * t + (-0.142248368f); q = q * t + 0.127414796f; q = q * t;
    const f32x2 s = (v * v) * (-0.72134752044f);
    f32x2 e; e.x = __builtin_amdgcn_exp2f(s.x); e.y = __builtin_amdgcn_exp2f(s.y);
    const f32x2 m = v * (q * e), r = v - m;
    f32x2 o; o.x = v.x < 0.f ? m.x : r.x; o.y = v.y < 0.f ? m.y : r.y; return o;
}

template <int ACT  > struct EpiBf16 {
    static constexpr bool PERM = true, AFTER_DRAIN = false, I8 = false; static_assert(ACT == 0 || ACT == 1, "EpiBf16: ACT is 0 (none) or 1 (gelu_pk)");
    bf16_t* O; int ldc; const float* bias; int split_cols; size_t split_stride; float scale0;
    __device__ __forceinline__ void operator()(const f32x4 (&acc)[2][2][4][2], const Unit& u, int wr, int wc, int fr, int fq) const {
        const int row0 = u.pm * BM + wr * 64 + fr; int colt = u.pn * BM; bf16_t* base = O;
        float sc = 1.f; if (split_cols) { const int t = colt / split_cols; base += (size_t)t * split_stride; colt -= t * split_cols; if (t == 0) sc = scale0; }
        const int col0 = colt + wc * 32 + 8 * fq, bcol0 = u.pn * BM + wc * 32 + 8 * fq;
        f32x4 bv[2][2];
#pragma unroll
        for (int bj = 0; bj < 2; ++bj)
#pragma unroll
            for (int n = 0; n < 2; ++n) bv[bj][n] = bias ? *(const f32x4*)(bias + bcol0 + bj * HALF + 4 * n) : (f32x4){0.f, 0.f, 0.f, 0.f};
#pragma unroll
        for (int ai = 0; ai < 2; ++ai)
#pragma unroll
            for (int m = 0; m < 4; ++m) { bf16_t* rowp = base + (size_t)(row0 + ai * HALF + m * 16) * ldc + col0;
#pragma unroll
                for (int bj = 0; bj < 2; ++bj) { f32x4 v0 = acc[ai][bj][m][0] + bv[bj][0], v1 = acc[ai][bj][m][1] + bv[bj][1];
                    if (ACT == 1) { f32x2 a = gelu_pk((f32x2){v0[0], v0[1]}), b = gelu_pk((f32x2){v0[2], v0[3]}), c = gelu_pk((f32x2){v1[0], v1[1]}), d = gelu_pk((f32x2){v1[2], v1[3]});
                        v0 = (f32x4){a.x, a.y, b.x, b.y}; v1 = (f32x4){c.x, c.y, d.x, d.y}; }
                    v0 = v0 * sc; v1 = v1 * sc; u32x4 w; w.x = cvt_pk_bf16(v0[0], v0[1]); w.y = cvt_pk_bf16(v0[2], v0[3]); w.z = cvt_pk_bf16(v1[0], v1[1]); w.w = cvt_pk_bf16(v1[2], v1[3]);
                    *(u32x4*)(rowp + bj * HALF) = w; } }
    }
};
typedef int i32x4 __attribute__((ext_vector_type(4)));
template <bool I8> struct AccOf { typedef f32x4 type; };
template <> struct AccOf<true> { typedef i32x4 type; };
__device__ __forceinline__ f32x4 mma16(bf16x8 b, bf16x8 a, f32x4 c) { return __builtin_amdgcn_mfma_f32_16x16x32_bf16(b, a, c, 0, 0, 0); }
__device__ __forceinline__ i32x4 mma16(bf16x8 b, bf16x8 a, i32x4 c) { return __builtin_amdgcn_mfma_i32_16x16x64_i8(__builtin_bit_cast(i32x4, b), __builtin_bit_cast(i32x4, a), c, 0, 0, 0); }
__device__ __forceinline__ f32x4 cvt4(i32x4 v) { return __builtin_convertvector(v, f32x4); }
constexpr int SCL_OFF = 131072 + 2048;
template <class E, class = void> struct ScalesLds { static constexpr bool value = false; };
template <class E> struct ScalesLds<E, decltype((void)E::SCALES_LDS)> { static constexpr bool value = E::SCALES_LDS; };
struct EpiBf16Q {
    static constexpr bool PERM = true, AFTER_DRAIN = false, I8 = true;
    bf16_t* O; int ldc; int split_cols; size_t split_stride; const float* sa; const float* sw;
    static constexpr bool SCALES_LDS = true;
    __device__ __forceinline__ const float* row_scales(const Unit& u) const { return sa + u.pm * BM; }
    __device__ __forceinline__ const float* col_scales(const Unit& u) const { return sw + u.pn * BM; }
    __device__ __forceinline__ void operator()(const i32x4 (&acc)[2][2][4][2], const Unit& u, int wr, int wc, int fr, int fq, const PG8_LAS float* sc) const {
        const int row0 = u.pm * BM + wr * 64 + fr; int colt = u.pn * BM; bf16_t* base = O;
        { const int t = colt / split_cols; base += (size_t)t * split_stride; colt -= t * split_cols; }
        const int col0 = colt + wc * 32 + 8 * fq;
        f32x4 wv[2][2];
#pragma unroll
        for (int bj = 0; bj < 2; ++bj)
#pragma unroll
            for (int n = 0; n < 2; ++n) wv[bj][n] = *(const PG8_LAS f32x4*)(sc + 256 + wc * 32 + 8 * fq + bj * HALF + 4 * n);
        float a8[2][4];
#pragma unroll
        for (int ai = 0; ai < 2; ++ai)
#pragma unroll
            for (int m = 0; m < 4; ++m) a8[ai][m] = sc[wr * 64 + fr + ai * HALF + m * 16];
        asm volatile("" ::: "memory");
#pragma unroll
        for (int ai = 0; ai < 2; ++ai)
#pragma unroll
            for (int m = 0; m < 4; ++m) { const int r = row0 + ai * HALF + m * 16; const float a = a8[ai][m]; bf16_t* rowp = base + (size_t)r * ldc + col0;
#pragma unroll
                for (int bj = 0; bj < 2; ++bj) { const f32x4 v0 = cvt4(acc[ai][bj][m][0]) * a * wv[bj][0], v1 = cvt4(acc[ai][bj][m][1]) * a * wv[bj][1];
                    u32x4 w; w.x = cvt_pk_bf16(v0[0], v0[1]); w.y = cvt_pk_bf16(v0[2], v0[3]); w.z = cvt_pk_bf16(v1[0], v1[1]); w.w = cvt_pk_bf16(v1[2], v1[3]);
                    *(u32x4*)(rowp + bj * HALF) = w; } }
    }
};
template <bool RES32> struct EpiResQ {
    static constexpr bool PERM = true, AFTER_DRAIN = false, I8 = true;
    const void* res; bf16_t* out; float alpha; const float* sa; const float* sw;
    __device__ __forceinline__ void operator()(const i32x4 (&acc)[2][2][4][2], const Unit& u, int wr, int wc, int fr, int fq) const {
        const int col0 = u.pn * BM + wc * 32 + 8 * fq, row0 = u.pm * BM + wr * 64 + fr;
        const size_t rbase = (size_t)row0 * 2048 + col0;
        f32x4 wv[2][2]; float a8[2][4];
#pragma unroll
        for (int bj = 0; bj < 2; ++bj)
#pragma unroll
            for (int n = 0; n < 2; ++n) wv[bj][n] = *(const f32x4*)(sw + col0 + bj * HALF + 4 * n);
#pragma unroll
        for (int ai = 0; ai < 2; ++ai)
#pragma unroll
            for (int m = 0; m < 4; ++m) a8[ai][m] = sa[row0 + ai * HALF + m * 16];
        if constexpr (!RES32) {
            u32x4 rr[2][4][2];
#pragma unroll
            for (int ai = 0; ai < 2; ++ai)
#pragma unroll
                for (int m = 0; m < 4; ++m)
#pragma unroll
                    for (int bj = 0; bj < 2; ++bj) rr[ai][m][bj] = *(const u32x4*)((const bf16_t*)res + rbase + (size_t)(ai * HALF + m * 16) * 2048 + bj * HALF);
            asm volatile("" ::: "memory");
#pragma unroll
            for (int ai = 0; ai < 2; ++ai)
#pragma unroll
                for (int m = 0; m < 4; ++m)
#pragma unroll
                    for (int bj = 0; bj < 2; ++bj) { const u32x4 r = rr[ai][m][bj]; const float a = a8[ai][m];
                        const f32x4 x0 = (f32x4){__uint_as_float(r.x << 16), __uint_as_float(r.x & 0xffff0000u), __uint_as_float(r.y << 16), __uint_as_float(r.y & 0xffff0000u)};
                        const f32x4 x1 = (f32x4){__uint_as_float(r.z << 16), __uint_as_float(r.z & 0xffff0000u), __uint_as_float(r.w << 16), __uint_as_float(r.w & 0xffff0000u)};
                        const f32x4 v0 = x0 * alpha + cvt4(acc[ai][bj][m][0]) * a * wv[bj][0], v1 = x1 * alpha + cvt4(acc[ai][bj][m][1]) * a * wv[bj][1];
                        u32x4 w; w.x = cvt_pk_bf16(v0[0], v0[1]); w.y = cvt_pk_bf16(v0[2], v0[3]); w.z = cvt_pk_bf16(v1[0], v1[1]); w.w = cvt_pk_bf16(v1[2], v1[3]);
                        *(u32x4*)(out + rbase + (size_t)(ai * HALF + m * 16) * 2048 + bj * HALF) = w; }
        } else {
            f32x4 xa[4][2][2]; u32x4 wo[4][2];
#pragma unroll
            for (int m = 0; m < 4; ++m)
#pragma unroll
                for (int bj = 0; bj < 2; ++bj) { const float* p = (const float*)res + rbase + (size_t)(m * 16) * 2048 + bj * HALF; xa[m][bj][0] = *(const f32x4*)p; xa[m][bj][1] = *(const f32x4*)(p + 4); }
            asm volatile("" ::: "memory");
#pragma unroll
            for (int m = 0; m < 4; ++m)
#pragma unroll
                for (int bj = 0; bj < 2; ++bj) { const float a = a8[0][m]; const f32x4 v0 = xa[m][bj][0] * alpha + cvt4(acc[0][bj][m][0]) * a * wv[bj][0], v1 = xa[m][bj][1] * alpha + cvt4(acc[0][bj][m][1]) * a * wv[bj][1];
                    wo[m][bj].x = cvt_pk_bf16(v0[0], v0[1]); wo[m][bj].y = cvt_pk_bf16(v0[2], v0[3]); wo[m][bj].z = cvt_pk_bf16(v1[0], v1[1]); wo[m][bj].w = cvt_pk_bf16(v1[2], v1[3]); }
            asm volatile("" : "+v"(wo[0][0]), "+v"(wo[0][1]), "+v"(wo[1][0]), "+v"(wo[1][1]), "+v"(wo[2][0]), "+v"(wo[2][1]), "+v"(wo[3][0]), "+v"(wo[3][1]));
#pragma unroll
            for (int m = 0; m < 4; ++m)
#pragma unroll
                for (int bj = 0; bj < 2; ++bj) { const float* p = (const float*)res + rbase + (size_t)(HALF + m * 16) * 2048 + bj * HALF; xa[m][bj][0] = *(const f32x4*)p; xa[m][bj][1] = *(const f32x4*)(p + 4); }
            asm volatile("" ::: "memory");
#pragma unroll
            for (int m = 0; m < 4; ++m)
#pragma unroll
                for (int bj = 0; bj < 2; ++bj) *(u32x4*)(out + rbase + (size_t)(m * 16) * 2048 + bj * HALF) = wo[m][bj];
#pragma unroll
            for (int m = 0; m < 4; ++m)
#pragma unroll
                for (int bj = 0; bj < 2; ++bj) { const float a = a8[1][m]; const f32x4 v0 = xa[m][bj][0] * alpha + cvt4(acc[1][bj][m][0]) * a * wv[bj][0], v1 = xa[m][bj][1] * alpha + cvt4(acc[1][bj][m][1]) * a * wv[bj][1];
                    u32x4 w; w.x = cvt_pk_bf16(v0[0], v0[1]); w.y = cvt_pk_bf16(v0[2], v0[3]); w.z = cvt_pk_bf16(v1[0], v1[1]); w.w = cvt_pk_bf16(v1[2], v1[3]);
                    *(u32x4*)(out + rbase + (size_t)(HALF + m * 16) * 2048 + bj * HALF) = w; }
        }
    }
};
struct EpiSwiGLUQ {
    static constexpr bool PERM = true, AFTER_DRAIN = false, I8 = true;
    bf16_t* H; const float* sa; const float* sw;
    __device__ __forceinline__ static float swi(float g, float u) { const float e = __builtin_amdgcn_exp2f(g * -1.4426950408889634f); return g * __builtin_amdgcn_rcpf(1.0f + e) * u; }
    static constexpr bool SCALES_LDS = true;
    __device__ __forceinline__ const float* row_scales(const Unit& u) const { return sa + u.pm * BM; }
    __device__ __forceinline__ const float* col_scales(const Unit& u) const { return sw + (size_t)u.ex * 4096 + u.pn * BM; }
    __device__ __forceinline__ void operator()(const i32x4 (&acc)[2][2][4][2], const Unit& u, int wr, int wc, int fr, int fq, const PG8_LAS float* sc) const {
        const int row0 = u.pm * BM + wr * 64 + fr, col0 = u.pn * HALF + wc * 32 + 8 * fq;
        const PG8_LAS float* swe = sc + 256 + wc * 32 + 8 * fq;
        const f32x4 wg0 = *(const PG8_LAS f32x4*)swe, wg1 = *(const PG8_LAS f32x4*)(swe + 4), wu0 = *(const PG8_LAS f32x4*)(swe + HALF), wu1 = *(const PG8_LAS f32x4*)(swe + HALF + 4);
        float a8[2][4];
#pragma unroll
        for (int ai = 0; ai < 2; ++ai)
#pragma unroll
            for (int m = 0; m < 4; ++m) a8[ai][m] = sc[wr * 64 + fr + ai * HALF + m * 16];
        asm volatile("" ::: "memory");
#pragma unroll
        for (int ai = 0; ai < 2; ++ai)
#pragma unroll
            for (int m = 0; m < 4; ++m) { const int r = row0 + ai * HALF + m * 16; const float a = a8[ai][m]; bf16_t* rowp = H + (size_t)r * 2048 + col0;
                const f32x4 g0 = cvt4(acc[ai][0][m][0]) * a * wg0, g1 = cvt4(acc[ai][0][m][1]) * a * wg1, u0 = cvt4(acc[ai][1][m][0]) * a * wu0, u1 = cvt4(acc[ai][1][m][1]) * a * wu1;
                const float h0 = swi(g0[0], u0[0]), h1 = swi(g0[1], u0[1]), h2 = swi(g0[2], u0[2]), h3 = swi(g0[3], u0[3]), h4 = swi(g1[0], u1[0]), h5 = swi(g1[1], u1[1]), h6 = swi(g1[2], u1[2]), h7 = swi(g1[3], u1[3]);
                u32x4 w; w.x = cvt_pk_bf16(h0, h1); w.y = cvt_pk_bf16(h2, h3); w.z = cvt_pk_bf16(h4, h5); w.w = cvt_pk_bf16(h6, h7);
                *(u32x4*)rowp = w; }
    }
};
struct EpiGateQ {
    static constexpr bool PERM = true, AFTER_DRAIN = false, I8 = true;
    bf16_t* Y; const float* sa; const float* sw;
    static constexpr bool SCALES_LDS = true;
    __device__ __forceinline__ const float* row_scales(const Unit& u) const { return sa + u.pm * BM; }
    __device__ __forceinline__ const float* col_scales(const Unit& u) const { return sw + (size_t)u.ex * 2048 + u.pn * BM; }
    __device__ __forceinline__ void operator()(const i32x4 (&acc)[2][2][4][2], const Unit& u, int wr, int wc, int fr, int fq, const PG8_LAS float* sc) const {
        const int row0 = u.pm * BM + wr * 64 + fr, col0 = u.pn * BM + wc * 32 + 8 * fq;
        const PG8_LAS float* swe = sc + 256 + wc * 32 + 8 * fq;
        f32x4 wv[2][2];
#pragma unroll
        for (int bj = 0; bj < 2; ++bj)
#pragma unroll
            for (int n = 0; n < 2; ++n) wv[bj][n] = *(const PG8_LAS f32x4*)(swe + bj * HALF + 4 * n);
        float g8[2][4];
#pragma unroll
        for (int ai = 0; ai < 2; ++ai)
#pragma unroll
            for (int m = 0; m < 4; ++m) g8[ai][m] = sc[wr * 64 + fr + ai * HALF + m * 16];
        asm volatile("" ::: "memory");
#pragma unroll
        for (int ai = 0; ai < 2; ++ai)
#pragma unroll
            for (int m = 0; m < 4; ++m) { const int r = row0 + ai * HALF + m * 16; const float gt = g8[ai][m]; bf16_t* rowp = Y + (size_t)r * 2048 + col0;
#pragma unroll
                for (int bj = 0; bj < 2; ++bj) { const f32x4 v0 = cvt4(acc[ai][bj][m][0]) * gt * wv[bj][0], v1 = cvt4(acc[ai][bj][m][1]) * gt * wv[bj][1];
                    u32x4 w; w.x = cvt_pk_bf16(v0[0], v0[1]); w.y = cvt_pk_bf16(v0[2], v0[3]); w.z = cvt_pk_bf16(v1[0], v1[1]); w.w = cvt_pk_bf16(v1[2], v1[3]);
                    *(u32x4*)(rowp + bj * HALF) = w; } }
    }
};
template <bool RES32> struct EpiResBf16 {
    static constexpr bool PERM = true, AFTER_DRAIN = false, I8 = false;
    const void* res; bf16_t* out; float alpha;
    __device__ __forceinline__ void operator()(const f32x4 (&acc)[2][2][4][2], const Unit& u, int wr, int wc, int fr, int fq) const {
        const int col0 = u.pn * BM + wc * 32 + 8 * fq;
        const size_t rbase = (size_t)(u.pm * BM + wr * 64 + fr) * 2048 + col0;
        if constexpr (!RES32) {
            u32x4 rr[2][4][2];
#pragma unroll
            for (int ai = 0; ai < 2; ++ai)
#pragma unroll
                for (int m = 0; m < 4; ++m)
#pragma unroll
                    for (int bj = 0; bj < 2; ++bj) rr[ai][m][bj] = *(const u32x4*)((const bf16_t*)res + rbase + (size_t)(ai * HALF + m * 16) * 2048 + bj * HALF);
            asm volatile("" ::: "memory");
#pragma unroll
            for (int ai = 0; ai < 2; ++ai)
#pragma unroll
                for (int m = 0; m < 4; ++m)
#pragma unroll
                    for (int bj = 0; bj < 2; ++bj) { const u32x4 r = rr[ai][m][bj];
                        const f32x4 x0 = (f32x4){__uint_as_float(r.x << 16), __uint_as_float(r.x & 0xffff0000u), __uint_as_float(r.y << 16), __uint_as_float(r.y & 0xffff0000u)};
                        const f32x4 x1 = (f32x4){__uint_as_float(r.z << 16), __uint_as_float(r.z & 0xffff0000u), __uint_as_float(r.w << 16), __uint_as_float(r.w & 0xffff0000u)};
                        const f32x4 v0 = x0 * alpha + acc[ai][bj][m][0], v1 = x1 * alpha + acc[ai][bj][m][1];
                        u32x4 w; w.x = cvt_pk_bf16(v0[0], v0[1]); w.y = cvt_pk_bf16(v0[2], v0[3]); w.z = cvt_pk_bf16(v1[0], v1[1]); w.w = cvt_pk_bf16(v1[2], v1[3]);
                        *(u32x4*)(out + rbase + (size_t)(ai * HALF + m * 16) * 2048 + bj * HALF) = w; }
        } else {
            f32x4 xa[4][2][2]; u32x4 wo[4][2];
#pragma unroll
            for (int m = 0; m < 4; ++m)
#pragma unroll
                for (int bj = 0; bj < 2; ++bj) { const float* p = (const float*)res + rbase + (size_t)(m * 16) * 2048 + bj * HALF; xa[m][bj][0] = *(const f32x4*)p; xa[m][bj][1] = *(const f32x4*)(p + 4); }
            asm volatile("" ::: "memory");
#pragma unroll
            for (int m = 0; m < 4; ++m)
#pragma unroll
                for (int bj = 0; bj < 2; ++bj) { const f32x4 v0 = xa[m][bj][0] * alpha + acc[0][bj][m][0], v1 = xa[m][bj][1] * alpha + acc[0][bj][m][1];
                    wo[m][bj].x = cvt_pk_bf16(v0[0], v0[1]); wo[m][bj].y = cvt_pk_bf16(v0[2], v0[3]); wo[m][bj].z = cvt_pk_bf16(v1[0], v1[1]); wo[m][bj].w = cvt_pk_bf16(v1[2], v1[3]); }
            asm volatile("" : "+v"(wo[0][0]), "+v"(wo[0][1]), "+v"(wo[1][0]), "+v"(wo[1][1]), "+v"(wo[2][0]), "+v"(wo[2][1]), "+v"(wo[3][0]), "+v"(wo[3][1]));
#pragma unroll
            for (int m = 0; m < 4; ++m)
#pragma unroll
                for (int bj = 0; bj < 2; ++bj) { const float* p = (const float*)res + rbase + (size_t)(HALF + m * 16) * 2048 + bj * HALF; xa[m][bj][0] = *(const f32x4*)p; xa[m][bj][1] = *(const f32x4*)(p + 4); }
            asm volatile("" ::: "memory");
#pragma unroll
            for (int m = 0; m < 4; ++m)
#pragma unroll
                for (int bj = 0; bj < 2; ++bj) *(u32x4*)(out + rbase + (size_t)(m * 16) * 2048 + bj * HALF) = wo[m][bj];
#pragma unroll
            for (int m = 0; m < 4; ++m)
#pragma unroll
                for (int bj = 0; bj < 2; ++bj) { const f32x4 v0 = xa[m][bj][0] * alpha + acc[1][bj][m][0], v1 = xa[m][bj][1] * alpha + acc[1][bj][m][1];
                    u32x4 w; w.x = cvt_pk_bf16(v0[0], v0[1]); w.y = cvt_pk_bf16(v0[2], v0[3]); w.z = cvt_pk_bf16(v1[0], v1[1]); w.w = cvt_pk_bf16(v1[2], v1[3]);
                    *(u32x4*)(out + rbase + (size_t)(HALF + m * 16) * 2048 + bj * HALF) = w; }
        }
    }
};
struct EpiSwiGLU {
    static constexpr bool PERM = true, AFTER_DRAIN = false, I8 = false;
    bf16_t* H;
    __device__ __forceinline__ static float swi(float g, float u) { const float e = __builtin_amdgcn_exp2f(g * -1.4426950408889634f); return g * __builtin_amdgcn_rcpf(1.0f + e) * u; }
    __device__ __forceinline__ void operator()(const f32x4 (&acc)[2][2][4][2], const Unit& u, int wr, int wc, int fr, int fq) const {
        const int row0 = u.pm * BM + wr * 64 + fr, col0 = u.pn * HALF + wc * 32 + 8 * fq;
#pragma unroll
        for (int ai = 0; ai < 2; ++ai)
#pragma unroll
            for (int m = 0; m < 4; ++m) { bf16_t* rowp = H + (size_t)(row0 + ai * HALF + m * 16) * 2048 + col0;
                const f32x4 g0 = acc[ai][0][m][0], g1 = acc[ai][0][m][1], u0 = acc[ai][1][m][0], u1 = acc[ai][1][m][1];
                u32x4 w; w.x = cvt_pk_bf16(swi(g0[0], u0[0]), swi(g0[1], u0[1])); w.y = cvt_pk_bf16(swi(g0[2], u0[2]), swi(g0[3], u0[3]));
                w.z = cvt_pk_bf16(swi(g1[0], u1[0]), swi(g1[1], u1[1])); w.w = cvt_pk_bf16(swi(g1[2], u1[2]), swi(g1[3], u1[3]));
                *(u32x4*)rowp = w; }
    }
};
struct EpiGateBf16 {
    static constexpr bool PERM = true, AFTER_DRAIN = false, I8 = false;
    bf16_t* Y; const float* gate;
    __device__ __forceinline__ void operator()(const f32x4 (&acc)[2][2][4][2], const Unit& u, int wr, int wc, int fr, int fq) const {
        const int row0 = u.pm * BM + wr * 64 + fr, col0 = u.pn * BM + wc * 32 + 8 * fq;
#pragma unroll
        for (int ai = 0; ai < 2; ++ai)
#pragma unroll
            for (int m = 0; m < 4; ++m) { const int r = row0 + ai * HALF + m * 16; const float gt = gate[r]; bf16_t* rowp = Y + (size_t)r * 2048 + col0;
#pragma unroll
                for (int bj = 0; bj < 2; ++bj) { const f32x4 v0 = acc[ai][bj][m][0] * gt, v1 = acc[ai][bj][m][1] * gt;
                    u32x4 w; w.x = cvt_pk_bf16(v0[0], v0[1]); w.y = cvt_pk_bf16(v0[2], v0[3]); w.z = cvt_pk_bf16(v1[0], v1[1]); w.w = cvt_pk_bf16(v1[2], v1[3]);
                    *(u32x4*)(rowp + bj * HALF) = w; } }
    }
};
struct MoeOrder {
    int nM, nN, nwg, G, c; const PG8_LAS int* blk_exp; size_t estride;
    __device__ __forceinline__ void init(int nblk, int N, int G_, int c_, const PG8_LAS int* be, size_t es) { nM = nblk; nN = N / BM; nwg = nM * nN; G = G_; c = c_; blk_exp = be; estride = es; }
    __device__ __forceinline__ bool next(int i, Unit& u) const {
        const long L = (long)i * G + c; if (L >= nwg) return false;
        int wgid = (int)L; { const int q = nwg / NXCD, r = nwg % NXCD, xcd = wgid % NXCD, off = wgid / NXCD; wgid = (xcd < r ? xcd * (q + 1) : r * (q + 1) + (xcd - r) * q) + off; }
        const int nig = WGM * nN, gid = wgid / nig, fm = gid * WGM, gsz = (nM - fm) < WGM ? (nM - fm) : WGM;
        u.pm = fm + ((wgid % nig) % gsz); u.pn = (wgid % nig) / gsz;
        u.ex = __builtin_amdgcn_readfirstlane(blk_exp[u.pm]); u.boff = (size_t)u.ex * estride; return true;
    }
    __device__ __forceinline__ void a_ready(const Unit&) const {}
    __device__ __forceinline__ void done(const Unit&) const {}
};
template <class Epi, class Sched, bool ALIGN_EPI = false, bool SP2 = false>
__device__ __forceinline__ void gemm_phase(PG8_LAS unsigned char* lds, const Gemm g, const Sched& S, const Epi& E, const int tid) {
    const int wid = __builtin_amdgcn_readfirstlane(tid >> 6), lane = tid & 63, wr = wid >> 2, wc = wid & 3, fr = lane & 15, fq = lane >> 4;
    const int K = g.K, nt = K / BK;
    unsigned voffA[2], voffB[2];
#pragma unroll
    for (int i = 0; i < 2; ++i) { int R, C; stage_rc(tid * 16 + i * 8192, R, C); const int Rb = Epi::PERM ? ((R & ~31) + perm32(R & 31)) : R;
        voffA[i] = (unsigned)(R * K + C) * 2u; voffB[i] = (unsigned)(Rb * K + C) * 2u; }
    const size_t kstep = (size_t)(BK * 2);
    const size_t hstep = (size_t)HALF * K * 2;
    const size_t tstep = 2 * hstep;
    const unsigned ldsw = (unsigned)wid * 1024u;
    const int aoff = lds_byte(wr * 64 + fr, fq * 8), boff = lds_byte(wc * 32 + fr, fq * 8);
#define PG8_SA(b, h) (((b) * 2 + (h)) * HTB)
#define PG8_SB(b, h) ((4 + (b) * 2 + (h)) * HTB)
#define PG8_STAGE(bufoff, gbase, voff) do { _Pragma("unroll") for (int _i = 0; _i < 2; ++_i) \
        __builtin_amdgcn_global_load_lds((const unsigned*)((const char*)(gbase) + (voff)[_i]), (PG8_LAS unsigned*)(lds + (bufoff) + ldsw + _i * 8192), 16, 0, 0); } while (0)
#define PG8_LDA(dst, b, h) do { _Pragma("unroll") for (int m = 0; m < 4; ++m) _Pragma("unroll") for (int k = 0; k < 2; ++k) dst[m][k] = *(const PG8_LAS bf16x8*)(lds + PG8_SA(b, h) + aoff + m * 2048 + k * 1024); } while (0)
#define PG8_LDB(dst, b, h) do { _Pragma("unroll") for (int n = 0; n < 2; ++n) _Pragma("unroll") for (int k = 0; k < 2; ++k) dst[n][k] = *(const PG8_LAS bf16x8*)(lds + PG8_SB(b, h) + boff + n * 2048 + k * 1024); } while (0)
#define PG8_MMA(ai, bj, At, Bt) do { __builtin_amdgcn_s_setprio(1); _Pragma("unroll") for (int m = 0; m < 4; ++m) _Pragma("unroll") for (int n = 0; n < 2; ++n) _Pragma("unroll") for (int k = 0; k < 2; ++k) \
        acc[ai][bj][m][n] = mma16(Bt[n][k], At[m][k], acc[ai][bj][m][n]); __builtin_amdgcn_s_setprio(0); } while (0)
#define PG8_WAIT_V(n) asm volatile("s_waitcnt vmcnt(" #n ")" ::: "memory")
#define PG8_WAIT_L(n) asm volatile("s_waitcnt lgkmcnt(" #n ")" ::: "memory")
#define PG8_BAR __builtin_amdgcn_s_barrier()
#define PG8_SCHED __builtin_amdgcn_sched_barrier(0)
    Unit cur, nxt; int ui = 0;
    if (!S.next(0, cur)) return;
    typedef typename AccOf<Epi::I8>::type acc_t;
    acc_t acc[2][2][4][2];
#pragma unroll
    for (int a = 0; a < 2; ++a)
#pragma unroll
        for (int b = 0; b < 2; ++b)
#pragma unroll
            for (int m = 0; m < 4; ++m)
#pragma unroll
                for (int n = 0; n < 2; ++n) acc[a][b][m][n] = acc_t{};
    bf16x8 At[4][2], B0[2][2], B1[2][2];
    const char* cA = (const char*)g.A + (size_t)cur.pm * tstep; const char* cB = (const char*)g.Bt + cur.boff + (size_t)cur.pn * tstep;
    S.a_ready(cur);
    if constexpr (SP2) {
        PG8_STAGE(PG8_SB(0, 0), cB, voffB); PG8_STAGE(PG8_SB(0, 1), cB + hstep, voffB); PG8_STAGE(PG8_SA(0, 0), cA, voffA); PG8_STAGE(PG8_SA(0, 1), cA + hstep, voffA);
        if (wr == 1) PG8_BAR;
        PG8_WAIT_V(2); PG8_BAR;
        PG8_STAGE(PG8_SB(1, 0), cB + kstep, voffB); PG8_STAGE(PG8_SA(1, 0), cA + kstep, voffA); PG8_STAGE(PG8_SB(1, 1), cB + hstep + kstep, voffB);
        PG8_WAIT_V(6); PG8_BAR;
    } else {
        PG8_STAGE(PG8_SB(0, 0), cB, voffB); PG8_STAGE(PG8_SA(0, 0), cA, voffA); PG8_STAGE(PG8_SB(0, 1), cB + hstep, voffB); PG8_STAGE(PG8_SA(0, 1), cA + hstep, voffA);
        if (wr == 1) PG8_BAR;
        PG8_WAIT_V(4); PG8_BAR;
        PG8_STAGE(PG8_SB(1, 0), cB + kstep, voffB); PG8_STAGE(PG8_SA(1, 0), cA + kstep, voffA); PG8_STAGE(PG8_SB(1, 1), cB + hstep + kstep, voffB);
        PG8_WAIT_V(6); PG8_BAR;
    }
    for (;;) {
        const bool has_next = S.next(ui + 1, nxt);
        if constexpr (ScalesLds<Epi>::value) { if (wid == 0) {
            PG8_LAS unsigned* sdst = (PG8_LAS unsigned*)(lds + SCL_OFF + (ui & 1) * 2048);
            __builtin_amdgcn_global_load_lds((const unsigned*)E.row_scales(cur) + lane * 4, sdst, 16, 0, 0);
            __builtin_amdgcn_global_load_lds((const unsigned*)E.col_scales(cur) + lane * 4, sdst + 256, 16, 0, 0); } }
        const char* nA = has_next ? (const char*)g.A + (size_t)nxt.pm * tstep : cA; const char* nB = has_next ? (const char*)g.Bt + nxt.boff + (size_t)nxt.pn * tstep : cB;
        for (int t = 0; t < nt; t += 2) {
            const bool last = (t == nt - 2);
            const char* a1 = cA + (size_t)(t + 1) * kstep;
            const char* a2 = last ? nA : cA + (size_t)(t + 2) * kstep; const char* b2 = last ? nB : cB + (size_t)(t + 2) * kstep;
            const char* a3 = a2 + kstep; const char* b3 = b2 + kstep;
            if (last && has_next) S.a_ready(nxt);
            if constexpr (SP2) {
            PG8_LDB(B0, 0, 0); PG8_LDB(B1, 0, 1); PG8_SCHED; PG8_LDA(At, 0, 0); PG8_STAGE(PG8_SA(1, 1), a1 + hstep, voffA);
            PG8_WAIT_V(8); PG8_WAIT_L(0); PG8_BAR; PG8_MMA(0, 0, At, B0); PG8_MMA(0, 1, At, B1); PG8_BAR; PG8_SCHED;
            PG8_LDA(At, 0, 1); PG8_STAGE(PG8_SB(0, 0), b2, voffB); PG8_STAGE(PG8_SB(0, 1), b2 + hstep, voffB); PG8_STAGE(PG8_SA(0, 0), a2, voffA);
            PG8_WAIT_V(8); PG8_WAIT_L(0); PG8_BAR; PG8_MMA(1, 0, At, B0); PG8_MMA(1, 1, At, B1); PG8_BAR; PG8_SCHED;
            PG8_LDB(B0, 1, 0); PG8_LDB(B1, 1, 1); PG8_SCHED; PG8_LDA(At, 1, 0); PG8_STAGE(PG8_SA(0, 1), a2 + hstep, voffA);
            PG8_WAIT_V(8); PG8_WAIT_L(0); PG8_BAR; PG8_MMA(0, 0, At, B0); PG8_MMA(0, 1, At, B1); PG8_BAR; PG8_SCHED;
            PG8_LDA(At, 1, 1); PG8_STAGE(PG8_SB(1, 0), b3, voffB); PG8_STAGE(PG8_SB(1, 1), b3 + hstep, voffB); PG8_STAGE(PG8_SA(1, 0), a3, voffA);
            PG8_WAIT_V(8); PG8_WAIT_L(0); PG8_BAR; PG8_MMA(1, 0, At, B0); PG8_MMA(1, 1, At, B1); PG8_BAR; PG8_SCHED;
            } else {
            PG8_LDB(B0, 0, 0); PG8_SCHED; PG8_LDA(At, 0, 0); PG8_STAGE(PG8_SA(1, 1), a1 + hstep, voffA);
            PG8_WAIT_L(8); PG8_BAR; PG8_WAIT_L(0); PG8_MMA(0, 0, At, B0); PG8_BAR; PG8_SCHED;
            PG8_LDB(B1, 0, 1); PG8_STAGE(PG8_SB(0, 0), b2, voffB);
            PG8_BAR; PG8_WAIT_L(0); PG8_MMA(0, 1, At, B1); PG8_BAR;
            PG8_LDA(At, 0, 1); PG8_STAGE(PG8_SA(0, 0), a2, voffA);
            PG8_BAR; PG8_WAIT_L(0); PG8_MMA(1, 0, At, B0); PG8_BAR; PG8_SCHED;
            PG8_STAGE(PG8_SB(0, 1), b2 + hstep, voffB);
            PG8_WAIT_V(6); PG8_BAR; PG8_MMA(1, 1, At, B1); PG8_BAR;
            PG8_LDB(B0, 1, 0); PG8_SCHED; PG8_LDA(At, 1, 0); PG8_STAGE(PG8_SA(0, 1), a2 + hstep, voffA);
            PG8_WAIT_L(8); PG8_BAR; PG8_WAIT_L(0); PG8_MMA(0, 0, At, B0); PG8_BAR; PG8_SCHED;
            PG8_LDB(B1, 1, 1); PG8_STAGE(PG8_SB(1, 0), b3, voffB);
            PG8_BAR; PG8_WAIT_L(0); PG8_MMA(0, 1, At, B1); PG8_BAR;
            PG8_LDA(At, 1, 1); PG8_STAGE(PG8_SA(1, 0), a3, voffA);
            PG8_BAR; PG8_WAIT_L(0); PG8_MMA(1, 0, At, B0); PG8_BAR; PG8_SCHED;
            PG8_STAGE(PG8_SB(1, 1), b3 + hstep, voffB);
            PG8_WAIT_V(6); PG8_BAR; PG8_MMA(1, 1, At, B1); PG8_BAR;
            }
        }
        if constexpr (ALIGN_EPI) { if (wr == 0) PG8_BAR; }
        if constexpr (!Epi::AFTER_DRAIN) { if constexpr (ScalesLds<Epi>::value) E(acc, cur, wr, wc, fr, fq, (const PG8_LAS float*)(lds + SCL_OFF + (ui & 1) * 2048)); else E(acc, cur, wr, wc, fr, fq); S.done(cur); }
        if (!has_next) break;
#pragma unroll
        for (int a = 0; a < 2; ++a)
#pragma unroll
            for (int b = 0; b < 2; ++b)
#pragma unroll
                for (int m = 0; m < 4; ++m)
#pragma unroll
                    for (int n = 0; n < 2; ++n) acc[a][b][m][n] = acc_t{};
        cur = nxt; cA = nA; cB = nB; ++ui;
        if constexpr (ALIGN_EPI) { if (wr == 1) PG8_BAR; }
    }
    PG8_WAIT_V(0);
    if constexpr (!ALIGN_EPI) { if (wr == 0) PG8_BAR; }
    PG8_BAR;
    if constexpr (Epi::AFTER_DRAIN) { E.fused(acc, cur, wr, wc, fr, fq, lds, wid, lane); S.done(cur); }
#undef PG8_SA
#undef PG8_SB
#undef PG8_STAGE
#undef PG8_LDA
#undef PG8_LDB
#undef PG8_MMA
#undef PG8_WAIT_V
#undef PG8_WAIT_L
#undef PG8_BAR
#undef PG8_SCHED
}
}
namespace att {
typedef unsigned short bf16_t;
typedef short bf16x8 __attribute__((ext_vector_type(8)));
typedef short s16x4 __attribute__((ext_vector_type(4)));
typedef float f32x16 __attribute__((ext_vector_type(16)));
typedef float f32x4 __attribute__((ext_vector_type(4)));
typedef unsigned u32x4 __attribute__((ext_vector_type(4)));
constexpr int NW = 8, QBLK = 32, KVBLK = 64, PITCH = 2048;
constexpr int SHM_V = KVBLK * 128 * 2, SHM_K = KVBLK * 128 * 2;
constexpr int OFF_WS = 2 * SHM_V + 2 * SHM_K;
constexpr int OFF_FK = OFF_WS + NW * 64 * 4;
constexpr int OFF_TAB = OFF_FK + 2 * 64 * 4;
constexpr int LDS_BYTES = OFF_TAB + 2 * 260 * 4;
constexpr float THR = 8.f;
#define ATT_GAS __attribute__((address_space(1)))
template <class T> __device__ __forceinline__ T ldg(const void* base, unsigned boff) { return *(const ATT_GAS T*)((const ATT_GAS char*)base + boff); }
template <class T> __device__ __forceinline__ void stg(void* base, unsigned boff, T v) { *(ATT_GAS T*)((ATT_GAS char*)base + boff) = v; }
#define KSWZ(row, colB) ((row) * 256 + ((colB) ^ (((row) & 7) << 4)))
#define SBAR() __builtin_amdgcn_sched_barrier(0)
__device__ __forceinline__ int v_st(int k, int c) { const int kk = (k & ~0xC) | ((k & 4) << 1) | ((k & 8) >> 1); return ((kk >> 3) * 4 + (c >> 5)) * 512 + ((kk & 7) * 32 + (c & 31)) * 2; }
__device__ __forceinline__ int v_rd_base(int lane) { return ((lane & 3) << 3) | (((lane >> 2) & 3) << 6) | (((lane >> 4) & 1) << 5) | (((lane >> 5) & 1) << 8); }
constexpr int v_rd_off(int d0, int ks, int half) { return d0 * 512 + ks * 4096 + half * 2048; }
__device__ __forceinline__ int crow(int r, int hi) { return (r & 3) + 8 * (r >> 2) + 4 * hi; }
__device__ __forceinline__ unsigned cvtpk(float lo, float hi) { unsigned r; asm volatile("v_cvt_pk_bf16_f32 %0, %1, %2" : "=v"(r) : "v"(lo), "v"(hi)); return r; }
__device__ __forceinline__ void mask_tile(f32x16& p0, f32x16& p1, int dq) {
    const float NEG = -__builtin_inff();
#pragma unroll
    for (int r = 0; r < 16; ++r) { const int c = (r & 3) + 8 * (r >> 2);
        if (dq - c < 0) p0[r] = NEG;
        if (dq - c - 32 < 0) p1[r] = NEG; }
}
template <int MODE> __device__ __forceinline__ void partialSM(f32x16& p0, f32x16& p1, float& m_reg, float& mn, float& alpha) {
    constexpr float SCALE = MODE == 0 ? 0.08838834764831845f : 0.125f;
    float pm0 = fmaxf(p0[0], p0[1]), pm1 = fmaxf(p0[2], p0[3]), pm2 = fmaxf(p1[0], p1[1]), pm3 = fmaxf(p1[2], p1[3]);
#pragma unroll
    for (int r = 4; r < 16; r += 4) { pm0 = fmaxf(fmaxf(pm0, p0[r]), p0[r + 1]); pm1 = fmaxf(fmaxf(pm1, p0[r + 2]), p0[r + 3]); pm2 = fmaxf(fmaxf(pm2, p1[r]), p1[r + 1]); pm3 = fmaxf(fmaxf(pm3, p1[r + 2]), p1[r + 3]); }
    float pmax = fmaxf(fmaxf(pm0, pm1), fmaxf(pm2, pm3));
    { auto rr = __builtin_amdgcn_permlane32_swap(__float_as_uint(pmax), __float_as_uint(pmax), false, false);
      pmax = fmaxf(__uint_as_float(rr[0]), __uint_as_float(rr[1])); }
    constexpr float C2 = 1.4426950408889634f * SCALE;
    if (__builtin_expect(__all((pmax - m_reg) * SCALE <= THR), 1)) { mn = m_reg; alpha = 1.f; }
    else { mn = fmaxf(m_reg, pmax); alpha = __builtin_amdgcn_exp2f((m_reg - mn) * C2); m_reg = mn; }
    const float mnL = -mn * C2;
#pragma unroll
    for (int r = 0; r < 16; ++r) p0[r] = fmaf(p0[r], C2, mnL);
#pragma unroll
    for (int r = 0; r < 16; ++r) p1[r] = fmaf(p1[r], C2, mnL);
#pragma unroll
    for (int r = 0; r < 16; ++r) p0[r] = __builtin_amdgcn_exp2f(p0[r]);
}
__device__ __forceinline__ void finishSM(f32x16& p0, f32x16& p1, float alpha, float& l_reg, bf16x8& pa0, bf16x8& pa1, bf16x8& pa2, bf16x8& pa3) {
#pragma unroll
    for (int r = 0; r < 16; ++r) p1[r] = __builtin_amdgcn_exp2f(p1[r]);
    float ps0 = p0[0], ps1 = p0[1], ps2 = p1[0], ps3 = p1[1];
#pragma unroll
    for (int r = 2; r < 16; r += 2) { ps0 += p0[r]; ps1 += p0[r + 1]; ps2 += p1[r]; ps3 += p1[r + 1]; }
    float ps = (ps0 + ps1) + (ps2 + ps3);
    { auto rr = __builtin_amdgcn_permlane32_swap(__float_as_uint(ps), __float_as_uint(ps), false, false);
      ps = __uint_as_float(rr[0]) + __uint_as_float(rr[1]); }
    l_reg = l_reg * alpha + ps;
#define PK4(P, B_, OUT) do { unsigned a0 = cvtpk(P[B_+0], P[B_+1]), a1 = cvtpk(P[B_+2], P[B_+3]);                          \
        unsigned b0 = cvtpk(P[B_+4], P[B_+5]), b1 = cvtpk(P[B_+6], P[B_+7]);                                             \
        auto r0 = __builtin_amdgcn_permlane32_swap(a0, b0, false, false); auto r1 = __builtin_amdgcn_permlane32_swap(a1, b1, false, false); \
        u32x4 w = {r0[0], r1[0], r0[1], r1[1]}; OUT = *reinterpret_cast<bf16x8*>(&w); } while (0)
    PK4(p0, 0, pa0); PK4(p0, 8, pa1); PK4(p1, 0, pa2); PK4(p1, 8, pa3);
#undef PK4
}
struct BiasCtx { float fq; int qi128; int cw; int hd; };
template <int KB, int MODE>
__device__ __forceinline__ void qkt(f32x16& p0, f32x16& p1, const char* lds, int r32, int hi, const bf16x8* qr, bool act, const BiasCtx& bc, int jt) {
    if (MODE == 1 && !act) { const float NEG = -__builtin_inff();
#pragma unroll
        for (int r = 0; r < 16; ++r) { p0[r] = NEG; p1[r] = NEG; } return; }
    if constexpr (MODE == 0) {
        const float* fk = (const float*)(lds + OFF_FK + KB * 256);
#pragma unroll
        for (int g = 0; g < 4; ++g) { const f32x4 f = *(const f32x4*)(fk + 8 * g + 4 * hi);
            p0[4 * g + 0] = bc.fq - f[0]; p0[4 * g + 1] = bc.fq - f[1]; p0[4 * g + 2] = bc.fq - f[2]; p0[4 * g + 3] = bc.fq - f[3]; }
#pragma unroll
        for (int g = 0; g < 4; ++g) { const f32x4 f = *(const f32x4*)(fk + 32 + 8 * g + 4 * hi);
            p1[4 * g + 0] = bc.fq - f[0]; p1[4 * g + 1] = bc.fq - f[1]; p1[4 * g + 2] = bc.fq - f[2]; p1[4 * g + 3] = bc.fq - f[3]; }
    } else {
        const float* tab = (const float*)(lds + OFF_TAB) + bc.hd * 260;
        const int delta = bc.cw - jt;
        if (delta >= 3) { const float c = tab[256];
#pragma unroll
            for (int r = 0; r < 16; ++r) { p0[r] = c; p1[r] = c; } }
        else { const int base = 64 * delta + bc.qi128 - 4 * hi;
#pragma unroll
            for (int r = 0; r < 16; ++r) { const int kj = (r & 3) + 8 * (r >> 2); int i0 = base - kj, i1 = base - kj - 32; i0 = i0 > 256 ? 256 : i0; i1 = i1 > 256 ? 256 : i1;
                p0[r] = tab[i0]; p1[r] = tab[i1]; } }
    }
    const char* K_lds = lds + 2 * SHM_V;
    const char* kb[4];
#pragma unroll
    for (int dd = 0; dd < 4; ++dd) kb[dd] = K_lds + KB * SHM_K + KSWZ(r32, (dd * 16 + hi * 8) * 2);
    if constexpr (MODE == 0) {
#pragma unroll
        for (int d0 = 0; d0 < 8; ++d0) { const char* a = kb[d0 & 3] + (d0 >> 2) * 128;
            const bf16x8 b0 = *reinterpret_cast<const bf16x8*>(a);
            const bf16x8 b1 = *reinterpret_cast<const bf16x8*>(a + 32 * 256);
            p0 = __builtin_amdgcn_mfma_f32_32x32x16_bf16(b0, qr[d0], p0, 0, 0, 0);
            p1 = __builtin_amdgcn_mfma_f32_32x32x16_bf16(b1, qr[d0], p1, 0, 0, 0); }
    } else {
#pragma unroll
        for (int dd = 0; dd < 4; ++dd) { const char* a = kb[dd] + bc.hd * 128;
            const bf16x8 b0 = *reinterpret_cast<const bf16x8*>(a);
            const bf16x8 b1 = *reinterpret_cast<const bf16x8*>(a + 32 * 256);
            p0 = __builtin_amdgcn_mfma_f32_32x32x16_bf16(b0, qr[dd], p0, 0, 0, 0);
            p1 = __builtin_amdgcn_mfma_f32_32x32x16_bf16(b1, qr[dd], p1, 0, 0, 0); }
    }
}
template <int VB, int ND>
__device__ __forceinline__ void pv_tile(f32x16* o, int vb0, bf16x8 pa0, bf16x8 pa1, bf16x8 pa2, bf16x8 pa3, bool act) {
    if (!act) return;
#define TRRD(dst, off) asm volatile("ds_read_b64_tr_b16 %0, %1 offset:%2" : "=&v"(dst) : "v"(vb0), "i"(off) : "memory")
#define PV_D0(d0) do { s16x4 l0, l1, l2, l3, h0, h1, h2, h3; constexpr int b_ = VB * SHM_V + v_rd_off(d0, 0, 0);   \
        TRRD(l0, b_); TRRD(h0, b_ + 2048); TRRD(l1, b_ + 4096); TRRD(h1, b_ + 6144); TRRD(l2, b_ + 8192); TRRD(h2, b_ + 10240); TRRD(l3, b_ + 12288); TRRD(h3, b_ + 14336); \
        asm volatile("s_waitcnt lgkmcnt(0)" : "+v"(l0), "+v"(l1), "+v"(l2), "+v"(l3), "+v"(h0), "+v"(h1), "+v"(h2), "+v"(h3));     \
        o[d0] = __builtin_amdgcn_mfma_f32_32x32x16_bf16(pa0, (bf16x8){l0[0], l0[1], l0[2], l0[3], h0[0], h0[1], h0[2], h0[3]}, o[d0], 0, 0, 0);   \
        o[d0] = __builtin_amdgcn_mfma_f32_32x32x16_bf16(pa1, (bf16x8){l1[0], l1[1], l1[2], l1[3], h1[0], h1[1], h1[2], h1[3]}, o[d0], 0, 0, 0);   \
        o[d0] = __builtin_amdgcn_mfma_f32_32x32x16_bf16(pa2, (bf16x8){l2[0], l2[1], l2[2], l2[3], h2[0], h2[1], h2[2], h2[3]}, o[d0], 0, 0, 0);   \
        o[d0] = __builtin_amdgcn_mfma_f32_32x32x16_bf16(pa3, (bf16x8){l3[0], l3[1], l3[2], l3[3], h3[0], h3[1], h3[2], h3[3]}, o[d0], 0, 0, 0); } while (0)
    PV_D0(0); PV_D0(1);
    if constexpr (ND == 4) { PV_D0(2); PV_D0(3); }
#undef PV_D0
#undef TRRD
}
struct Blk { const bf16_t* Q; const bf16_t* K; const bf16_t* V; bf16_t* O; const float* F; const float* tab; int P0; int j_lo; };
template <int MODE>
__device__ __forceinline__ void attn_block(const Blk& cur, char* lds, const int tid) {
    constexpr int ND = MODE == 0 ? 4 : 2, NQ = MODE == 0 ? 8 : 4;
    constexpr float INVS = 11.313708498984761f;
    const int wid = __builtin_amdgcn_readfirstlane(tid >> 6), lane = tid & 63, r32 = lane & 31, hi = lane >> 5;
    const int hd = MODE == 1 ? (wid >> 2) : 0, rb = MODE == 1 ? (wid & 3) : wid;
    const int C0 = cur.P0 / KVBLK;
    int j_lo, j_hi;
    if (MODE == 0) { j_lo = cur.j_lo; j_hi = C0 + 4; } else { j_lo = C0 - 8 < 0 ? 0 : C0 - 8; j_hi = C0 + 2; }
    const int NT = j_hi - j_lo;
    const int qlo = cur.P0 + rb * QBLK, qm = qlo + r32 - 4 * hi;
    BiasCtx bc; bc.fq = 0.f; bc.hd = hd; bc.cw = C0 + (rb >> 1); bc.qi128 = (rb & 1) * 32 + r32 + 128;
    char* V_lds = lds; char* K_lds = lds + 2 * SHM_V;
    float* ws = (float*)(lds + OFF_WS) + wid * 64; float* li_l = ws; float* al_l = ws + 32;
    float m_reg = -1e30f, l_reg = 0; f32x16 o[ND];
#pragma unroll
    for (int d = 0; d < ND; ++d) o[d] = f32x16{};
    const int sr = tid >> 4, sc = (tid & 15) * 8, vst0 = v_st(sr, sc), kws = KSWZ(sr, sc * 2);
    const int vb0 = (int)(uintptr_t)V_lds + v_rd_base(lane) + hd * 1024;
    const bf16_t* Kh = cur.K; const bf16_t* Vh = cur.V;
    bf16x8 st_v0, st_v1, st_k0, st_k1; float st_f = 0.f, fref = 0.f;
    const unsigned goff0 = (unsigned)(sr * PITCH + sc) * 2u, goff1 = goff0 + 32u * PITCH * 2u;
#define VMW() asm volatile("s_waitcnt vmcnt(0)" ::: "memory")
#define SLOAD_H(k0) do { const bf16_t* vt_ = Vh + (size_t)(k0) * PITCH; const bf16_t* kt_ = Kh + (size_t)(k0) * PITCH;                \
                         st_v0 = ldg<bf16x8>(vt_, goff0); st_v1 = ldg<bf16x8>(vt_, goff1); st_k0 = ldg<bf16x8>(kt_, goff0); st_k1 = ldg<bf16x8>(kt_, goff1); \
                         if (MODE == 0 && wid == 0) st_f = ldg<float>(cur.F + (k0), (unsigned)lane * 4u); } while (0)
#define SWRITE_HK(bf) do { *(bf16x8*)(K_lds + (bf) * SHM_K + kws) = st_k0; *(bf16x8*)(K_lds + (bf) * SHM_K + kws + 32 * 256) = st_k1; \
                           if (MODE == 0 && wid == 0) *(float*)(lds + OFF_FK + (bf) * 256 + lane * 4) = (st_f - fref) * INVS; } while (0)
#define SWRITE_HV(bf) do { *(bf16x8*)(V_lds + (bf) * SHM_V + vst0) = st_v0; *(bf16x8*)(V_lds + (bf) * SHM_V + vst0 + 8192) = st_v1; } while (0)
#define SWRITE_H(bf) do { SWRITE_HV(bf); SWRITE_HK(bf); } while (0)
#define RESC(a) do { if (__any((a) < 1.f)) { if (hi == 0) al_l[r32] = (a); asm volatile("s_waitcnt lgkmcnt(0)" ::: "memory");              \
                     _Pragma("unroll") for (int d_ = 0; d_ < ND; ++d_) _Pragma("unroll") for (int r = 0; r < 16; ++r) o[d_][r] *= al_l[crow(r, hi)]; } } while (0)
#define KBASE(t) ((j_lo + (t)) * KVBLK)
#define ACT(t) (MODE == 0 ? true : ((j_lo + (t)) >= bc.cw - 8 && (j_lo + (t)) <= bc.cw))
#define MASKT(P0_, P1_, t) do { if (MODE == 0) { const int kb_ = KBASE(t); if (kb_ + KVBLK - 1 > qlo) mask_tile(P0_, P1_, qm - kb_); } } while (0)
    bf16x8 qr[NQ];
    { const unsigned qoff = (unsigned)((rb * QBLK + r32) * PITCH + hd * 64 + hi * 8) * 2u;
#pragma unroll
      for (int d0 = 0; d0 < NQ; ++d0) qr[d0] = ldg<bf16x8>(cur.Q, qoff + d0 * 32u); }
    if constexpr (MODE == 0) { fref = __uint_as_float(__builtin_amdgcn_readfirstlane(__float_as_uint(ldg<float>(cur.F + cur.P0, 0u)))); bc.fq = (ldg<float>(cur.F + qlo, (unsigned)r32 * 4u) - fref) * INVS; }
    else { float* tab = (float*)(lds + OFF_TAB); for (int i = tid; i < 2 * 257; i += 64 * NW) { const int h2 = i >= 257 ? 1 : 0; tab[h2 * 260 + (i - h2 * 257)] = cur.tab[i] * 8.0f; } }
    SLOAD_H(KBASE(0)); VMW(); SWRITE_HK(0);
    __syncthreads();
    f32x16 pA0, pA1, pB0, pB1; float mnA, mnB, alA, alB; bf16x8 pa0, pa1, pa2, pa3;
    SWRITE_HV(0); SBAR();
    if (NT > 1) SLOAD_H(KBASE(1));
    SBAR(); qkt<0, MODE>(pA0, pA1, lds, r32, hi, qr, ACT(0), bc, j_lo);
    MASKT(pA0, pA1, 0); partialSM<MODE>(pA0, pA1, m_reg, mnA, alA);
    if (NT > 1) { VMW(); SWRITE_H(1); }
    __syncthreads();
#define HALF_STEP(PX0, PX1, mnX, alX, PY0, PY1, alY, t, KB, VB, SB) do {                                                      \
        SBAR(); qkt<KB, MODE>(PX0, PX1, lds, r32, hi, qr, ACT(t), bc, j_lo + (t));                                            \
        finishSM(PY0, PY1, alY, l_reg, pa0, pa1, pa2, pa3); SBAR();                                                           \
        if ((t) + 1 < NT) { SLOAD_H(KBASE((t) + 1)); SBAR(); }                                                               \
        pv_tile<VB, ND>(o, vb0, pa0, pa1, pa2, pa3, ACT((t) - 1)); MASKT(PX0, PX1, (t)); partialSM<MODE>(PX0, PX1, m_reg, mnX, alX);  \
        __syncthreads();                                                                                                      \
        if ((t) + 1 < NT) { VMW(); SWRITE_H(SB); }                                                                            \
        RESC(alX); __syncthreads(); } while (0)
    for (int t = 1; t + 1 < NT; t += 2) {
        HALF_STEP(pB0, pB1, mnB, alB, pA0, pA1, alA, t, 1, 0, 0);
        HALF_STEP(pA0, pA1, mnA, alA, pB0, pB1, alB, t + 1, 0, 1, 1);
    }
    const bool even = (NT & 1) == 0;
    if (even) { SBAR(); qkt<1, MODE>(pB0, pB1, lds, r32, hi, qr, ACT(NT - 1), bc, j_lo + NT - 1); SBAR(); }
    finishSM(pA0, pA1, alA, l_reg, pa0, pa1, pa2, pa3); SBAR();
    pv_tile<0, ND>(o, vb0, pa0, pa1, pa2, pa3, ACT(even ? NT - 2 : NT - 1));
    if (even) { MASKT(pB0, pB1, NT - 1); partialSM<MODE>(pB0, pB1, m_reg, mnB, alB); __syncthreads(); RESC(alB);
        finishSM(pB0, pB1, alB, l_reg, pa0, pa1, pa2, pa3); SBAR(); pv_tile<1, ND>(o, vb0, pa0, pa1, pa2, pa3, ACT(NT - 1)); }
    if (hi == 0) li_l[r32] = l_reg; asm volatile("s_waitcnt lgkmcnt(0)" ::: "memory");
    float rli[16];
#pragma unroll
    for (int r = 0; r < 16; ++r) rli[r] = __builtin_amdgcn_rcpf(li_l[crow(r, hi)]);
    bf16_t* Ow = cur.O + (size_t)(rb * QBLK) * PITCH + hd * 64;
    int le = lane; asm volatile("" : "+v"(le));
    const unsigned ooff = (unsigned)(4 * (le >> 5) * PITCH + (le & 31)) * 2u;
#pragma unroll
    for (int r = 0; r < 16; ++r) { const unsigned orow = (r & 3) + 8 * (r >> 2);
#pragma unroll
        for (int d0 = 0; d0 < ND; ++d0) { const float v = o[d0][r] * rli[r]; const float vn = __shfl_xor(v, 1);
            if ((r32 & 1) == 0) stg<unsigned>(Ow, ooff + (orow * PITCH + d0 * 32) * 2u, cvtpk(v, vn)); } }
    __syncthreads();
#undef VMW
#undef SLOAD_H
#undef SWRITE_HK
#undef SWRITE_HV
#undef SWRITE_H
#undef RESC
#undef KBASE
#undef ACT
#undef MASKT
#undef HALF_STEP
}
#undef KSWZ
#undef SBAR
}
constexpr int NWAVES = 8;
constexpr int N_LAUNCHES = MK_N_LAUNCHES;
constexpr int N_PHASES = 22;
constexpr int NB = 2, SEQ = 16384, DM = 2048, N_TOK = NB * SEQ, NE = 16;
constexpr int CH_TOK = 128, N_CH = N_TOK / CH_TOK;
constexpr int MAX_BLK = 272, MAX_SLOT = MAX_BLK * 256;
constexpr float ALPHA = 1.4142135623730951f, LN_EPS = 1e-5f;

constexpr size_t MiB = 1u << 20;
constexpr size_t WS_CTL = 0, CTL_ZERO_BYTES = 1 * MiB;
constexpr size_t WS_SMALL = 2 * MiB;
constexpr size_t SM_TOKE = 0, SM_TOKG = 256 * 1024, SM_SLOTOF = 512 * 1024, SM_SLOTG = 768 * 1024;
constexpr size_t SM_WGCNT = 1088 * 1024, SM_BLK = 1104 * 1024, SM_CHT = 1108 * 1024;
constexpr size_t SM_DMIN = 1128 * 1024;
constexpr size_t SM_FLOC = 2 * MiB, SM_FF = 4 * MiB;
constexpr size_t SM_ASCX = 6 * MiB, SM_ASC1 = SM_ASCX + 128 * 1024, SM_ASC2 = SM_ASC1 + 128 * 1024, SM_SLOTSC = SM_ASC2 + 128 * 1024;
constexpr size_t SM_WSCQKV = 7 * MiB, SM_WSCKVQ = SM_WSCQKV + 32 * 1024, SM_WSCGU = SM_WSCKVQ + 32 * 1024, SM_WSCD = SM_WSCGU + 576 * 1024;
constexpr size_t SM_WSCAO = SM_WSCD + 256 * 1024, SM_WSCBO = SM_WSCAO + 8 * 1024;
constexpr size_t SM_HSC = 8 * MiB, SM_ASCAO = SM_HSC + 512 * 1024;
constexpr size_t WS_WQKV8 = 12 * MiB, WS_WKVQ8 = 24 * MiB;
constexpr size_t WS_WAO = 36 * MiB, WS_WBO = 44 * MiB;
constexpr size_t WS_WGU8 = 52 * MiB;
constexpr size_t WS_WD8 = 308 * MiB;
constexpr size_t WS_HMAX = 436 * MiB;
constexpr size_t WS_R1 = 454 * MiB;
constexpr size_t WS_R2 = 726 * MiB;
constexpr size_t WS_R3 = 854 * MiB;
constexpr size_t WS_XA8 = 982 * MiB, WS_XQ8 = 1046 * MiB;
constexpr size_t WS_R4 = 1110 * MiB;
constexpr size_t WS_R5 = 1494 * MiB;
constexpr size_t WS_END = 1630 * MiB;
constexpr int CW_BAR = 4096;
constexpr int CW_QHEAD2 = 8448;
constexpr int CW_NORM = 8192, CW_QHEAD = 8320;

constexpr int RING_BYTES = 131072;
constexpr int MISC_OFF = RING_BYTES;
constexpr int TBL_OFF = RING_BYTES + 256;
constexpr int LF_OFF = RING_BYTES + 2048;
constexpr int GB_OFF = LF_OFF + 8192;
constexpr int LDS_BYTES = 163840;
static_assert(GB_OFF + 16384 <= LDS_BYTES && att::LDS_BYTES <= RING_BYTES, "LDS map");

#define GAS __attribute__((address_space(1)))
#define LAS __attribute__((address_space(3)))
typedef unsigned short bf16;
typedef unsigned v4u __attribute__((ext_vector_type(4)));
typedef float f32x4 __attribute__((ext_vector_type(4)));
typedef short bf16x8 __attribute__((ext_vector_type(8)));
typedef GAS unsigned gu32;
typedef GAS unsigned long long gu64;
#define RLX_AGENT __ATOMIC_RELAXED, __HIP_MEMORY_SCOPE_AGENT
#define LDS_WAIT() asm volatile("s_waitcnt lgkmcnt(0)" ::: "memory")
#define VM_WAIT() asm volatile("s_waitcnt vmcnt(0)" ::: "memory")
__device__ __forceinline__ unsigned long long rt() { return __builtin_amdgcn_s_memrealtime(); }
__device__ __forceinline__ unsigned f2bf(float f) { unsigned u = __builtin_bit_cast(unsigned, f); return (u + 0x7fffu + ((u >> 16) & 1u)) >> 16; }
__device__ __forceinline__ unsigned pk2(float lo, float hi) { return f2bf(lo) | (f2bf(hi) << 16); }

#define XB_TMO      128
#define XB_XCNT(j)  (256  + 64 * (j))
#define XB_XSUB(j)  (1280 + 64 * (j))
#define XB_XGEN(j)  (2304 + 64 * (j))
#define XB_TOP      3328
#define XB_TOPGEN   3392
#define XCD_BAR_WORDS 3456
#define XB_SPIN_CAP (1u << 18)

__device__ __forceinline__ unsigned xb_ld(unsigned* p)              { return __hip_atomic_load(p, __ATOMIC_RELAXED, __HIP_MEMORY_SCOPE_AGENT); }
__device__ __forceinline__ unsigned xb_add(unsigned* p, unsigned v) { return __hip_atomic_fetch_add(p, v, __ATOMIC_RELAXED, __HIP_MEMORY_SCOPE_AGENT); }
__device__ __forceinline__ unsigned xb_xcc_id() { return (unsigned)__builtin_amdgcn_s_getreg((3 << 11) | 20) & 0xFu; }
#define XB_SPIN(cond, bar) do { unsigned _sp = 0; while (cond) { __builtin_amdgcn_s_sleep(1); \
    if ((++_sp & 255u) == 0u) { if (xb_ld(&(bar)[XB_TMO])) break; if (_sp > XB_SPIN_CAP) { atomicAdd(&(bar)[XB_TMO], 1u); break; } } } } while (0)

struct XcdBarrier {
    unsigned* bar; unsigned x;
    volatile LAS unsigned* st;
};

__device__ __forceinline__ XcdBarrier xcd_barrier_post(unsigned* bar, volatile LAS unsigned* st, const bool tid0  ) {
    XcdBarrier b; b.bar = bar; b.x = xb_xcc_id(); b.st = st;
    if (tid0) (void)xb_add(&bar[XB_XCNT(b.x)], 1u);
    return b;
}
__device__ __forceinline__ void xcd_barrier_complete(unsigned* bar, unsigned x, unsigned& nloc, unsigned& nx) {
    const unsigned G = gridDim.x * gridDim.y * gridDim.z;
    unsigned sum, cnt, mine, sp = 0u;
    for (;;) {
        sum = 0u; cnt = 0u; mine = 0u;
#pragma unroll
        for (unsigned j = 0; j < 16; ++j) { const unsigned c = xb_ld(&bar[XB_XCNT(j)]); sum += c; cnt += (c > 0u) ? 1u : 0u; mine = (j == x) ? c : mine; }
        if (sum == G) break;
        __builtin_amdgcn_s_sleep(1);
        if ((++sp & 255u) == 0u) { if (xb_ld(&bar[XB_TMO])) break; if (sp > XB_SPIN_CAP) { atomicAdd(&bar[XB_TMO], 1u); break; } }
    }
    nloc = mine > 0u ? mine : 1u; nx = cnt > 0u ? cnt : 1u;
}

__device__ __forceinline__ void xcd_barrier(const XcdBarrier& b, const bool tid0  ) {
    asm volatile("s_waitcnt vmcnt(0)" ::: "memory");
    __syncthreads();
    if (tid0) {
        unsigned* bar = b.bar;
        __builtin_amdgcn_s_waitcnt(0);
        unsigned nloc = b.st[0], nx = b.st[1];
        if (nloc == 0u) { xcd_barrier_complete(bar, b.x, nloc, nx); b.st[0] = nloc; b.st[1] = nx; }
        const unsigned old = xb_add(&bar[XB_XSUB(b.x)], 1u);
        const unsigned gen = old / nloc;
        if (old + 1u == (gen + 1u) * nloc) {
            __builtin_amdgcn_fence(__ATOMIC_RELEASE, "agent");
            asm volatile("s_waitcnt vmcnt(0)" ::: "memory");
            const unsigned og = xb_add(&bar[XB_TOP], 1u);
            const unsigned tg = og / nx;
            if (og + 1u == (tg + 1u) * nx) xb_add(&bar[XB_TOPGEN], 1u);
            else XB_SPIN(xb_ld(&bar[XB_TOPGEN]) == tg, bar);
            __builtin_amdgcn_fence(__ATOMIC_ACQUIRE, "agent");
            xb_add(&bar[XB_XGEN(b.x)], 1u);
            asm volatile("s_waitcnt vmcnt(0)" ::: "memory");
        } else {
            XB_SPIN(xb_ld(&bar[XB_XGEN(b.x)]) == gen, bar);
            __builtin_amdgcn_fence(__ATOMIC_ACQUIRE, "agent");
            asm volatile("s_waitcnt vmcnt(0)" ::: "memory");
        }
    }
    __syncthreads();
}

struct Frame {
    LAS unsigned char* lds;
    volatile LAS unsigned* MISC;
    int tid, lane, wave;
    int vcu, G;
};
struct Ptrs {
    const float *x, *w_qkv, *rel_bias, *w_ao, *w_kv, *fg_w, *fg_b, *w_bq, *w_bo, *router_w, *router_b, *w_gate, *w_up, *w_down, *ln_gain, *ln_bias;
    float* out;
    unsigned char *Wqkv8, *Wkvq8, *Wao8, *Wbo8, *Wgu8, *Wd8, *XA8, *XQ8, *XS8, *HID8, *AO8;
    float *wsc_qkv, *wsc_kvq, *wsc_ao, *wsc_bo, *wsc_gu, *wsc_d, *asc_x, *asc_1, *asc_2, *asc_ao, *slot_sc, *hsc, *hmax;
    bf16 *SH, *XA, *XB, *QKV, *XS, *AO;
    int *tok_e, *slot_of, *wgcnt, *blk; float *tok_g, *slot_g, *cht, *floc, *ff, *dmin;
};

typedef unsigned u32x2 __attribute__((ext_vector_type(2)));
#define MEMFENCE() asm volatile("" ::: "memory")
template <class T> __device__ __forceinline__ T ldg(const void* base, unsigned boff) { return *(const GAS T*)((const GAS char*)base + boff); }
template <class T> __device__ __forceinline__ void stg(void* base, unsigned boff, T v) { *(GAS T*)((GAS char*)base + boff) = v; }
template <int CTRL, int RMASK> __device__ __forceinline__ float dpp_mov0(float v) { return __int_as_float(__builtin_amdgcn_update_dpp(0, __float_as_int(v), CTRL, RMASK, 0xf, false)); }
__device__ __forceinline__ float wave_sum(float v) {
    v += dpp_mov0<0xB1, 0xf>(v); v += dpp_mov0<0x4E, 0xf>(v); v += dpp_mov0<0x141, 0xf>(v); v += dpp_mov0<0x140, 0xf>(v);
    v += dpp_mov0<0x142, 0xa>(v); v += dpp_mov0<0x143, 0xc>(v);
    return __uint_as_float(__builtin_amdgcn_readlane(__float_as_uint(v), 63));
}
__device__ __forceinline__ float wave_max_nonneg(float v) {
    v = fmaxf(v, dpp_mov0<0xB1, 0xf>(v)); v = fmaxf(v, dpp_mov0<0x4E, 0xf>(v)); v = fmaxf(v, dpp_mov0<0x141, 0xf>(v)); v = fmaxf(v, dpp_mov0<0x140, 0xf>(v));
    v = fmaxf(v, dpp_mov0<0x142, 0xa>(v)); v = fmaxf(v, dpp_mov0<0x143, 0xc>(v));
    return __uint_as_float(__builtin_amdgcn_readlane(__float_as_uint(v), 63));
}
constexpr int CV8_EXPERT_STRIPS = 16 * 3 * 64;
__device__ __forceinline__ void cv8_strip(Frame& F, const float* src, int ldw, int n0, unsigned char* dst8, int drow0, float* wsc) {
    LAS float* scr = (LAS float*)(F.lds + F.wave * 16384);
    LAS float* cmx = (LAS float*)(F.lds + F.wave * 16384 + 12288);
    const int lane = F.lane, kw = F.wave * 256;
    float r[4][32];
#pragma unroll
    for (int q = 0; q < 4; ++q) { const float* p = src + (size_t)(kw + 64 * q) * ldw + n0;
        const unsigned lo = (unsigned)((lane >> 5) * ldw + (lane & 31)) * 4u, st = (unsigned)ldw * 8u;
#pragma unroll
        for (int i = 0; i < 32; ++i) r[q][i] = __builtin_nontemporal_load((const GAS float*)((const GAS char*)p + (lo + i * st))); }
    float m = 0.f;
#pragma unroll
    for (int q = 0; q < 4; ++q)
#pragma unroll
        for (int i = 0; i < 32; ++i) m = fmaxf(m, fabsf(r[q][i]));
    m = fmaxf(m, __shfl_xor(m, 32));
    if (lane < 32) cmx[lane] = m;
    __syncthreads();
    float cm = 0.f;
#pragma unroll
    for (int w = 0; w < NWAVES; ++w) cm = fmaxf(cm, ((LAS float*)(F.lds + w * 16384 + 12288))[lane & 31]);
    const float inv = cm > 0.f ? 127.f / cm : 0.f;
    if (F.wave == 0 && lane < 32) wsc[drow0 + lane] = cm * (1.f / 127.f);
    const int c4 = lane & 3;
#pragma unroll
    for (int q = 0; q < 4; ++q) {
#pragma unroll
        for (int i = 0; i < 32; ++i) scr[(2 * i + (lane >> 5)) * 33 + (lane & 31)] = r[q][i] * inv;
        LDS_WAIT(); asm volatile("" ::: "memory");
#pragma unroll
        for (int h = 0; h < 2; ++h) { const int n = (lane >> 2) + 16 * h; const LAS float* s2 = scr + (16 * c4) * 33 + n; unsigned w[4];
#pragma unroll
            for (int d = 0; d < 4; ++d) { const int q0 = __float2int_rn(s2[(4 * d) * 33]), q1 = __float2int_rn(s2[(4 * d + 1) * 33]), q2 = __float2int_rn(s2[(4 * d + 2) * 33]), q3 = __float2int_rn(s2[(4 * d + 3) * 33]);
                w[d] = (unsigned)(q0 & 255) | ((unsigned)(q1 & 255) << 8) | ((unsigned)(q2 & 255) << 16) | ((unsigned)q3 << 24); }
            const v4u o = {w[0], w[1], w[2], w[3]};
            *(GAS v4u*)(dst8 + (size_t)(drow0 + n) * 2048 + kw + 64 * q + 16 * c4) = o; }
        LDS_WAIT(); asm volatile("" ::: "memory");
    }
    __syncthreads();
}
__device__ __forceinline__ void cv8_dense(Frame& F, const Ptrs& P, int sid) {
    const int b8 = sid >> 6, n0 = (sid & 63) * 32;
    const float* src; int ldw = 2048; unsigned char* dst; float* wsc;
    if (b8 < 3) { src = P.w_qkv + b8 * 2048; ldw = 6144; dst = P.Wqkv8 + (size_t)b8 * 2048 * 2048; wsc = P.wsc_qkv + b8 * 2048; }
    else if (b8 < 5) { src = P.w_kv + (b8 - 3) * 2048; ldw = 4096; dst = P.Wkvq8 + (size_t)(b8 - 3) * 2048 * 2048; wsc = P.wsc_kvq + (b8 - 3) * 2048; }
    else if (b8 == 5) { src = P.w_bq; dst = P.Wkvq8 + (size_t)2 * 2048 * 2048; wsc = P.wsc_kvq + 4096; }
    else if (b8 == 6) { src = P.w_ao; dst = P.Wao8; wsc = P.wsc_ao; }
    else { src = P.w_bo; dst = P.Wbo8; wsc = P.wsc_bo; }
    cv8_strip(F, src, ldw, n0, dst, n0, wsc);
}
__device__ __forceinline__ void cv8_expert(Frame& F, const Ptrs& P, int layer, int sid) {
    const int e = sid / 192, rr = sid - e * 192, kind = rr >> 6, n0 = (rr & 63) * 32, le = layer * 16 + e;
    const float* src; unsigned char* dst; float* wsc; int drow0;
    if (kind == 2) { src = P.w_down + (size_t)le * 2048 * 2048; dst = P.Wd8 + (size_t)le * 2048 * 2048; wsc = P.wsc_d + (size_t)le * 2048; drow0 = n0; }
    else { src = (kind ? P.w_up : P.w_gate) + (size_t)le * 2048 * 2048; dst = P.Wgu8 + (size_t)le * 4096 * 2048; wsc = P.wsc_gu + (size_t)le * 4096; drow0 = 256 * (n0 >> 7) + (n0 & 127) + 128 * kind; }
    cv8_strip(F, src, 2048, n0, dst, drow0, wsc);
}
__device__ __forceinline__ void cv_side(Frame& F, const Ptrs& P, int layer) {
    if (F.G < 8) { for (int sid = F.vcu; sid < CV8_EXPERT_STRIPS; sid += F.G) cv8_expert(F, P, layer, sid); return; }
    if ((F.vcu & 1) != 1) return;
    const int ncv = F.G >> 1, rank = F.vcu >> 1;
#pragma unroll 1
    for (int sid = rank; sid < CV8_EXPERT_STRIPS; sid += ncv) cv8_expert(F, P, layer, sid);
}
__device__ __forceinline__ float quant_row_store(unsigned char* dst, const f32x4 (&v)[8], int lane) {
    float m = 0.f;
#pragma unroll
    for (int j = 0; j < 8; ++j) m = fmaxf(fmaxf(m, fmaxf(fabsf(v[j].x), fabsf(v[j].y))), fmaxf(fabsf(v[j].z), fabsf(v[j].w)));
    m = wave_max_nonneg(m);
    const float inv = m > 0.f ? 127.f / m : 0.f;
#pragma unroll
    for (int j = 0; j < 8; ++j) { const int q0 = __float2int_rn(v[j].x * inv), q1 = __float2int_rn(v[j].y * inv), q2 = __float2int_rn(v[j].z * inv), q3 = __float2int_rn(v[j].w * inv);
        stg<unsigned>(dst, (unsigned)(64 * j + lane) * 4u, (unsigned)(q0 & 255) | ((unsigned)(q1 & 255) << 8) | ((unsigned)(q2 & 255) << 16) | ((unsigned)q3 << 24)); }
    return m * (1.f / 127.f);
}
__device__ __forceinline__ void p0_prologue(Frame& F, const Ptrs& P) {
#pragma unroll 1
    for (int sid = F.vcu; sid < 512; sid += F.G) cv8_dense(F, P, sid);
#pragma unroll 1
    for (int t = (F.vcu * NWAVES + F.wave) * 4; t < N_TOK; t += F.G * NWAVES * 4) {
        int ln = F.lane; asm volatile("" : "+v"(ln));
        f32x4 v[4][8];
#pragma unroll
        for (int q = 0; q < 4; ++q)
#pragma unroll
            for (int j = 0; j < 8; ++j) v[q][j] = ldg<f32x4>(P.x + (size_t)(t + q) * DM, (unsigned)(64 * j + ln) * 16u);
#pragma unroll
        for (int q = 0; q < 4; ++q) { const float sc = quant_row_store(P.XA8 + (size_t)(t + q) * DM, v[q], ln);
            if (ln == 0) P.asc_x[t + q] = sc; }
    }
}
__device__ __forceinline__ void load_wT(Frame& F, const float* W) {
    LAS float* wT = (LAS float*)F.lds;
    for (int i = F.tid; i < 2048 * 16; i += NWAVES * 64) wT[(i & 15) * 2048 + (i >> 4)] = W[i];
}
__device__ __forceinline__ void ln2rows(f32x4 (&v0)[8], f32x4 (&v1)[8], const LAS f32x4* gb  ) {
    float s0 = 0.f, s1 = 0.f;
#pragma unroll
    for (int j = 0; j < 8; ++j) { s0 += (v0[j].x + v0[j].y) + (v0[j].z + v0[j].w); s1 += (v1[j].x + v1[j].y) + (v1[j].z + v1[j].w); }
    const float m0 = wave_sum(s0) * (1.f / DM), m1 = wave_sum(s1) * (1.f / DM);
    float q0 = 0.f, q1 = 0.f;
#pragma unroll
    for (int j = 0; j < 8; ++j) { v0[j] = v0[j] - m0; v1[j] = v1[j] - m1;
        q0 += (v0[j].x * v0[j].x + v0[j].y * v0[j].y) + (v0[j].z * v0[j].z + v0[j].w * v0[j].w);
        q1 += (v1[j].x * v1[j].x + v1[j].y * v1[j].y) + (v1[j].z * v1[j].z + v1[j].w * v1[j].w); }
    const float r0 = 1.f / sqrtf(wave_sum(q0) * (1.f / DM) + LN_EPS), r1 = 1.f / sqrtf(wave_sum(q1) * (1.f / DM) + LN_EPS);
#pragma unroll
    for (int j = 0; j < 8; ++j) { const f32x4 g = gb[64 * j], b = gb[512 + 64 * j]; v0[j] = v0[j] * r0 * g + b; v1[j] = v1[j] * r1 * g + b; }
}
__device__ __forceinline__ void load_gb(Frame& F, const float* gain, const float* bias) {
    LAS f32x4* d = (LAS f32x4*)(F.lds + GB_OFF);
    d[F.tid] = ldg<f32x4>(gain, (unsigned)F.tid * 16u); d[512 + F.tid] = ldg<f32x4>(bias, (unsigned)F.tid * 16u);
}
typedef float v2f __attribute__((ext_vector_type(2)));
__device__ __forceinline__ int dot_lane(int r, int e) { return 2 * (16 * r + e); }
__device__ __forceinline__ float dot16x2(Frame& F, const f32x4 (&y0)[8], const f32x4 (&y1)[8]) {
    const LAS f32x4* wp = (const LAS f32x4*)F.lds + F.lane;
    const int lane = F.lane;
    float a[32];
    f32x4 wa[8], wb[8];
#define DOT_LD(W, E) _Pragma("unroll") for (int j = 0; j < 8; ++j) W[j] = wp[(E) * 512 + 64 * j];
#define DOT_MAC(W, E) { v2f c0 = {0.f, 0.f}, c1 = {0.f, 0.f};                                                                                                   \
        _Pragma("unroll") for (int j = 0; j < 8; ++j) { const v2f wl = {W[j].x, W[j].y}, wh = {W[j].z, W[j].w};                                                   \
            c0 = __builtin_elementwise_fma((v2f){y0[j].x, y0[j].y}, wl, c0); c0 = __builtin_elementwise_fma((v2f){y0[j].z, y0[j].w}, wh, c0);                     \
            c1 = __builtin_elementwise_fma((v2f){y1[j].x, y1[j].y}, wl, c1); c1 = __builtin_elementwise_fma((v2f){y1[j].z, y1[j].w}, wh, c1); }                   \
        const float r0_ = c0.x + c0.y, r1_ = c1.x + c1.y; a[E] = r0_; a[16 + (E)] = r1_; asm volatile("" : "+v"(wp) : "v"(r0_), "v"(r1_)); }
    DOT_LD(wa, 0)
#pragma unroll
    for (int e = 0; e < 16; e += 2) {
        DOT_LD(wb, e + 1)
        DOT_MAC(wa, e)
        if (e + 2 < 16) { DOT_LD(wa, e + 2) }
        DOT_MAC(wb, e + 1)
    }
#undef DOT_LD
#undef DOT_MAC
#define R32_STEP(N, BIT) _Pragma("unroll") for (int k = 0; k < (N) / 2; ++k) { const bool up = (lane >> (BIT)) & 1; const float keep = up ? a[k + (N) / 2] : a[k], send = up ? a[k] : a[k + (N) / 2]; a[k] = keep + __shfl_xor(send, 1 << (BIT)); }
    R32_STEP(32, 5) R32_STEP(16, 4) R32_STEP(8, 3) R32_STEP(4, 2) R32_STEP(2, 1)
#undef R32_STEP
    return a[0] + __shfl_xor(a[0], 1);
}
__device__ __forceinline__ f32x4 unpack4(u32x2 r) { return (f32x4){__uint_as_float(r.x << 16), __uint_as_float(r.x & 0xffff0000u), __uint_as_float(r.y << 16), __uint_as_float(r.y & 0xffff0000u)}; }
__device__ __forceinline__ void store_row_bf16(bf16* dst  , const f32x4 (&v)[8], int lane) {
#pragma unroll
    for (int j = 0; j < 8; ++j) stg<unsigned long long>(dst, (unsigned)(64 * j + lane) * 8u, (unsigned long long)pk2(v[j].x, v[j].y) | ((unsigned long long)pk2(v[j].z, v[j].w) << 32));
}
__device__ __forceinline__ void store_row_f32(float* dst  , const f32x4 (&v)[8], int lane) {
#pragma unroll
    for (int j = 0; j < 8; ++j) stg<f32x4>(dst, (unsigned)(64 * j + lane) * 16u, v[j]);
}
__device__ __forceinline__ void route16(const float (&lg)[16], const float* rb, int& e0, int& e1, float& g0, float& g1) {
    float l[16]; float m = -__builtin_inff();
#pragma unroll
    for (int e = 0; e < 16; ++e) { l[e] = lg[e] + rb[e]; m = fmaxf(m, l[e]); }
    float p[16];
#pragma unroll
    for (int e = 0; e < 16; ++e) p[e] = __expf(l[e] - m);
    int bg = 0; float bs = -1.f;
#pragma unroll
    for (int g = 0; g < 4; ++g) { const float a0 = p[4 * g], a1 = p[4 * g + 1], a2 = p[4 * g + 2], a3 = p[4 * g + 3];
        const float h1 = fmaxf(a0, a1), l1 = fminf(a0, a1), h2 = fmaxf(a2, a3), l2 = fminf(a2, a3);
        const float top = fmaxf(h1, h2), sec = fmaxf(fminf(h1, h2), h1 >= h2 ? l1 : l2), sc = top + sec;
        if (sc > bs) { bs = sc; bg = g; } }
    float a[4];
#pragma unroll
    for (int i = 0; i < 4; ++i) a[i] = bg == 0 ? p[i] : bg == 1 ? p[4 + i] : bg == 2 ? p[8 + i] : p[12 + i];
    float va = a[0], vb = -1.f; int ia = 0, ib = 0;
#pragma unroll
    for (int i = 1; i < 4; ++i) { if (a[i] > va) { vb = va; ib = ia; va = a[i]; ia = i; } else if (a[i] > vb) { vb = a[i]; ib = i; } }
    const float inv = 1.f / (va + vb);
    e0 = 4 * bg + ia; e1 = 4 * bg + ib; g0 = va * inv; g1 = vb * inv;
}
__device__ __forceinline__ void ln1_route_phase(Frame& F, const Ptrs& P, int layer, const bf16* S_in, bf16* X_out) {
    load_wT(F, P.router_w);
    LAS int* hist = (LAS int*)(F.lds + TBL_OFF);
    load_gb(F, P.ln_gain + (size_t)(layer * 2 + 0) * DM, P.ln_bias + (size_t)(layer * 2 + 0) * DM);
    float rb[16];
#pragma unroll
    for (int e = 0; e < 16; ++e) rb[e] = P.router_b[e];
    for (int ch = F.vcu; ch < N_CH; ch += F.G) {
        if (F.tid < 16) hist[F.tid] = 0;
        __syncthreads();
#pragma unroll 1
        for (int qd = 0; qd < 4; ++qd) {
            const int tq = ch * CH_TOK + F.wave * 16 + 4 * qd;
            int ln = F.lane; asm volatile("" : "+v"(ln));
            u32x2 ra0[8], ra1[8], rc0[8], rc1[8];
            { const bf16* p0 = S_in + (size_t)tq * DM;
              MEMFENCE();
#pragma unroll
              for (int j = 0; j < 8; ++j) { ra0[j] = ldg<u32x2>(p0, (unsigned)(64 * j + ln) * 8u); ra1[j] = ldg<u32x2>(p0 + DM, (unsigned)(64 * j + ln) * 8u); }
#pragma unroll
              for (int j = 0; j < 8; ++j) { rc0[j] = ldg<u32x2>(p0 + 2 * DM, (unsigned)(64 * j + ln) * 8u); rc1[j] = ldg<u32x2>(p0 + 3 * DM, (unsigned)(64 * j + ln) * 8u); }
              MEMFENCE(); }
            auto pair = [&](const u32x2 (&r0)[8], const u32x2 (&r1)[8], const int t0) {
                f32x4 v0[8], v1[8];
#pragma unroll
                for (int j = 0; j < 8; ++j) { v0[j] = unpack4(r0[j]); v1[j] = unpack4(r1[j]); }
                ln2rows(v0, v1, (const LAS f32x4*)(F.lds + GB_OFF) + ln);
                store_row_bf16(X_out + (size_t)t0 * DM, v0, ln); store_row_bf16(X_out + (size_t)(t0 + 1) * DM, v1, ln);
                { const float sc0 = quant_row_store(P.XQ8 + (size_t)t0 * DM, v0, ln), sc1 = quant_row_store(P.XQ8 + (size_t)(t0 + 1) * DM, v1, ln);
                  if (ln == 0) { P.asc_1[t0] = sc0; P.asc_1[t0 + 1] = sc1; } }
                const float mine = dot16x2(F, v0, v1);
                float lg[16];
#pragma unroll
                for (int e = 0; e < 16; ++e) { const float s0 = __uint_as_float(__builtin_amdgcn_readlane(__float_as_uint(mine), dot_lane(0, e))), s1 = __uint_as_float(__builtin_amdgcn_readlane(__float_as_uint(mine), dot_lane(1, e))); lg[e] = F.lane == 1 ? s1 : s0; }
                int e0, e1; float g0, g1;
                route16(lg, rb, e0, e1, g0, g1);
                if (F.lane < 2) { const int t = t0 + F.lane; P.tok_e[2 * t] = e0; P.tok_e[2 * t + 1] = e1; P.tok_g[2 * t] = g0; P.tok_g[2 * t + 1] = g1;
                    __hip_atomic_fetch_add(&hist[e0], 1, __ATOMIC_RELAXED, __HIP_MEMORY_SCOPE_WORKGROUP); __hip_atomic_fetch_add(&hist[e1], 1, __ATOMIC_RELAXED, __HIP_MEMORY_SCOPE_WORKGROUP); }
            };
            pair(ra0, ra1, tq);
            asm volatile("" : "+v"(ln));
            pair(rc0, rc1, tq + 2);
        }
        __syncthreads();
        if (F.tid < 16) P.wgcnt[ch * 16 + F.tid] = hist[F.tid];
        __syncthreads();
    }
}
__device__ __forceinline__ void scatter_phase(Frame& F, const Ptrs& P) {
    LAS int* cnt = (LAS int*)F.lds;
    LAS int* psum = cnt + 4096;
    LAS int* tot = psum + 512; LAS int* pst = tot + 16; LAS int* bas = pst + 16;
    LAS int* elist = bas + 16; LAS int* slist = elist + 256;
    for (int ch = F.vcu; ch < N_CH; ch += F.G) {
        { int cv[8];
#pragma unroll
          for (int k = 0; k < 8; ++k) cv[k] = P.wgcnt[F.tid + k * NWAVES * 64];
#pragma unroll
          for (int k = 0; k < 8; ++k) cnt[F.tid + k * NWAVES * 64] = cv[k]; }
        __syncthreads();
        { const int p = F.tid >> 4, e = F.tid & 15; int s = 0;
#pragma unroll
          for (int c = 0; c < 8; ++c) s += cnt[(8 * p + c) * 16 + e];
          psum[p * 16 + e] = s; }
        __syncthreads();
        if (F.tid < 16) { const int e = F.tid, mp = ch >> 3; int run = 0, mb = 0;
            for (int p = 0; p < 32; ++p) { if (p == mp) mb = run; run += psum[p * 16 + e]; }
            for (int c = 8 * mp; c < ch; ++c) mb += cnt[c * 16 + e];
            tot[e] = run; bas[e] = mb; }
        __syncthreads();
        if (F.tid == 0) { int ps = 0;
            for (int e = 0; e < 16; ++e) { pst[e] = ps; const int pd = (tot[e] + 255) & ~255;
                if (ch == 0) for (int bq = ps >> 8; bq < ((ps + pd) >> 8); ++bq) P.blk[16 + bq] = e;
                ps += pd; }
            if (ch == 0) P.blk[0] = ps >> 8; }
        __syncthreads();
        if (F.tid < 256) elist[F.tid] = P.tok_e[2 * (ch * CH_TOK) + F.tid];
        __syncthreads();
        if (F.tid < 256) { const int e = elist[F.tid]; int rank = 0;
            for (int q = 0; q < F.tid; ++q) rank += (elist[q] == e) ? 1 : 0;
            const int slot = pst[e] + bas[e] + rank; slist[F.tid] = slot;
            P.slot_of[2 * (ch * CH_TOK) + F.tid] = slot; P.slot_g[slot] = P.tok_g[2 * (ch * CH_TOK) + F.tid]; P.slot_sc[slot] = P.asc_1[ch * CH_TOK + (F.tid >> 1)]; }
        __syncthreads();
#pragma unroll 1
        for (int q0 = 0; q0 < 32; q0 += 8) {
            v4u c[8][2];
#pragma unroll
            for (int i = 0; i < 8; ++i) { const int pi = F.wave * 32 + q0 + i, tok = ch * CH_TOK + (pi >> 1);
                const GAS v4u* src = (const GAS v4u*)(P.XQ8 + (size_t)tok * DM) + F.lane; c[i][0] = src[0]; c[i][1] = src[64]; }
            asm volatile("" ::: "memory");
#pragma unroll
            for (int i = 0; i < 8; ++i) { const int slot = slist[F.wave * 32 + q0 + i];
                GAS v4u* dst = (GAS v4u*)(P.XS8 + (size_t)slot * DM) + F.lane; dst[0] = c[i][0]; dst[64] = c[i][1]; }
        }
        if (ch < 16) { const int e = ch, lo = pst[e] + tot[e], hi = pst[e] + ((tot[e] + 255) & ~255); const v4u z = {0u, 0u, 0u, 0u};
            for (int s = lo + F.wave; s < hi; s += NWAVES) { GAS v4u* dst = (GAS v4u*)(P.XS8 + (size_t)s * DM) + F.lane; dst[0] = z; dst[64] = z; if (F.lane == 0) { P.slot_g[s] = 0.f; P.slot_sc[s] = 0.f; } } }
        __syncthreads();
    }
}
__device__ __forceinline__ void combine_ln2_phase(Frame& F, const Ptrs& P, int layer, const bf16* X_in, float* out_f, bf16* out_b) {
    const bool fg = layer == 0;
    if (fg) load_wT(F, P.fg_w);
    LAS float* lf = (LAS float*)(F.lds + LF_OFF);
    load_gb(F, P.ln_gain + (size_t)(layer * 2 + 1) * DM, P.ln_bias + (size_t)(layer * 2 + 1) * DM);
    float fb[16];
#pragma unroll
    for (int e = 0; e < 16; ++e) fb[e] = P.fg_b[e];
    __syncthreads();
    for (int ch = F.vcu; ch < N_CH; ch += F.G) {
        const int myslots = P.slot_of[2 * (ch * CH_TOK + F.wave * 16) + (F.lane & 31)];
#pragma unroll 1
        for (int pr = 0; pr < 8; ++pr) {
            const int r0 = F.wave * 16 + 2 * pr, t0 = ch * CH_TOK + r0;
            int ln = F.lane; asm volatile("" : "+v"(ln));
            f32x4 v0[8], v1[8];
            { const bf16* p0 = X_in + (size_t)t0 * DM; const bf16* p1 = p0 + DM;
              const int s00 = __builtin_amdgcn_readlane(myslots, 4 * pr), s01 = __builtin_amdgcn_readlane(myslots, 4 * pr + 1);
              const int s10 = __builtin_amdgcn_readlane(myslots, 4 * pr + 2), s11 = __builtin_amdgcn_readlane(myslots, 4 * pr + 3);
              const bf16* y00 = P.XS + (size_t)s00 * DM; const bf16* y01 = P.XS + (size_t)s01 * DM; const bf16* y10 = P.XS + (size_t)s10 * DM; const bf16* y11 = P.XS + (size_t)s11 * DM;
              MEMFENCE();
#pragma unroll
              for (int j = 0; j < 8; ++j) { const unsigned ix = (unsigned)(64 * j + ln);
                  const f32x4 x0 = unpack4(ldg<u32x2>(p0, ix * 8u)), x1 = unpack4(ldg<u32x2>(p1, ix * 8u)); const u32x2 a = ldg<u32x2>(y00, ix * 8u), c = ldg<u32x2>(y01, ix * 8u), d = ldg<u32x2>(y10, ix * 8u), e = ldg<u32x2>(y11, ix * 8u);
                  v0[j].x = x0.x * ALPHA + (__uint_as_float(a.x << 16) + __uint_as_float(c.x << 16)); v0[j].y = x0.y * ALPHA + (__uint_as_float(a.x & 0xffff0000u) + __uint_as_float(c.x & 0xffff0000u));
                  v0[j].z = x0.z * ALPHA + (__uint_as_float(a.y << 16) + __uint_as_float(c.y << 16)); v0[j].w = x0.w * ALPHA + (__uint_as_float(a.y & 0xffff0000u) + __uint_as_float(c.y & 0xffff0000u));
                  v1[j].x = x1.x * ALPHA + (__uint_as_float(d.x << 16) + __uint_as_float(e.x << 16)); v1[j].y = x1.y * ALPHA + (__uint_as_float(d.x & 0xffff0000u) + __uint_as_float(e.x & 0xffff0000u));
                  v1[j].z = x1.z * ALPHA + (__uint_as_float(d.y << 16) + __uint_as_float(e.y << 16)); v1[j].w = x1.w * ALPHA + (__uint_as_float(d.y & 0xffff0000u) + __uint_as_float(e.y & 0xffff0000u));
                  if (j & 1) MEMFENCE(); } }
            ln2rows(v0, v1, (const LAS f32x4*)(F.lds + GB_OFF) + ln);
            if (out_f) { store_row_f32(out_f + (size_t)t0 * DM, v0, ln); store_row_f32(out_f + (size_t)(t0 + 1) * DM, v1, ln); }
            if (out_b) { store_row_bf16(out_b + (size_t)t0 * DM, v0, ln); store_row_bf16(out_b + (size_t)(t0 + 1) * DM, v1, ln);
                const float sc0 = quant_row_store(P.XA8 + (size_t)t0 * DM, v0, ln), sc1 = quant_row_store(P.XA8 + (size_t)(t0 + 1) * DM, v1, ln);
                if (ln == 0) { P.asc_2[t0] = sc0; P.asc_2[t0 + 1] = sc1; } }
            if (fg) {
                float z = dot16x2(F, v0, v1);
                const int hh = (F.lane >> 1) & 15;
#pragma unroll
                for (int e = 0; e < 16; ++e) z += hh == e ? fb[e] : 0.f;
                const float az = fabsf(z), lsg = fminf(z, 0.f) - log1pf(__expf(-az));
                if ((F.lane & 1) == 0) lf[(r0 + (F.lane >> 5)) * 16 + hh] = lsg;
            }
        }
        if (fg) {
            __syncthreads();
            if (F.tid < 16) { float run = 0.f; for (int i = 0; i < CH_TOK; ++i) { run += lf[i * 16 + F.tid]; lf[i * 16 + F.tid] = run; } P.cht[ch * 16 + F.tid] = run; }
            __syncthreads();
            for (int i = F.tid; i < CH_TOK * 16; i += NWAVES * 64) P.floc[(size_t)ch * CH_TOK * 16 + i] = lf[i];
            __syncthreads();
        }
    }
}
__device__ __forceinline__ void f_finalize(Frame& F, const Ptrs& P) {
    LAS float* bas = (LAS float*)(F.lds + TBL_OFF);
    for (int ch = F.vcu; ch < N_CH; ch += F.G) {
        const int b = ch >> 7, ci = ch & 127;
        { LAS float* part = bas + 16;
          const int h = F.tid & 15, p4 = F.tid >> 4; float s = 0.f;
#pragma unroll
          for (int k = 0; k < 4; ++k) { const int c = 4 * p4 + k; s += c < ci ? P.cht[(b * 128 + c) * 16 + h] : 0.f; }
          part[p4 * 16 + h] = s; }
        __syncthreads();
        if (F.tid < 16) { LAS float* part = bas + 16; float s = 0.f;
#pragma unroll
            for (int p = 0; p < 32; ++p) s += part[p * 16 + F.tid];
            bas[F.tid] = s; }
        __syncthreads();
        { float fv[4];
#pragma unroll
          for (int k = 0; k < 4; ++k) { const int i = F.tid + k * NWAVES * 64, h = i >> 7, s = i & 127; fv[k] = P.floc[(size_t)ch * CH_TOK * 16 + s * 16 + h]; }
#pragma unroll
          for (int k = 0; k < 4; ++k) { const int i = F.tid + k * NWAVES * 64, h = i >> 7, s = i & 127; P.ff[(size_t)(b * 16 + h) * SEQ + ci * CH_TOK + s] = bas[h] + fv[k]; } }
        __syncthreads();
    }
}
__device__ __forceinline__ int ord_f32(float f) { const int b = __float_as_int(f); return b >= 0 ? b : b ^ 0x7fffffff; }
__device__ __forceinline__ void qk_norms(Frame& F, const bf16* Q, const bf16* K, gu32* nrm  , float* dmin  ) {
    LAS unsigned* lm = (LAS unsigned*)(F.lds + TBL_OFF);
    LAS int* ld = (LAS int*)(lm + 32);
    for (int ch = F.vcu; ch < N_CH; ch += F.G) {
        if (F.tid < 32) lm[F.tid] = 0u;
        if (F.tid < 16) ld[F.tid] = 0x7fffffff;
        __syncthreads();
        float mq = 0.f, mk = 0.f, md = __builtin_inff();
#pragma unroll 1
        for (int r = F.wave; r < CH_TOK; r += 4 * NWAVES) {
            int ln = F.lane; asm volatile("" : "+v"(ln));
            v4u a[4][4], c[4][4];
#pragma unroll
            for (int k = 0; k < 4; ++k) { const size_t tok = (size_t)ch * CH_TOK + r + NWAVES * k;
#pragma unroll
                for (int i = 0; i < 4; ++i) { a[k][i] = ldg<v4u>(Q + tok * DM, (unsigned)ln * 64u + i * 16u); c[k][i] = ldg<v4u>(K + tok * DM, (unsigned)ln * 64u + i * 16u); } }
#pragma unroll
            for (int k = 0; k < 4; ++k) { float sq = 0.f, sk = 0.f, dq = 0.f;
#pragma unroll
                for (int i = 0; i < 4; ++i)
#pragma unroll
                    for (int w = 0; w < 4; ++w) { const float a0 = __uint_as_float(a[k][i][w] << 16), a1 = __uint_as_float(a[k][i][w] & 0xffff0000u), c0 = __uint_as_float(c[k][i][w] << 16), c1 = __uint_as_float(c[k][i][w] & 0xffff0000u);
                        sq += a0 * a0 + a1 * a1; sk += c0 * c0 + c1 * c1; dq += a0 * c0 + a1 * c1; }
                sq += __shfl_xor(sq, 1); sq += __shfl_xor(sq, 2); sk += __shfl_xor(sk, 1); sk += __shfl_xor(sk, 2); dq += __shfl_xor(dq, 1); dq += __shfl_xor(dq, 2);
                mq = fmaxf(mq, sq); mk = fmaxf(mk, sk); md = fminf(md, dq); }
        }
        if ((F.lane & 3) == 0) { __hip_atomic_fetch_max(&lm[F.lane >> 2], __float_as_uint(mq), __ATOMIC_RELAXED, __HIP_MEMORY_SCOPE_WORKGROUP);
                                 __hip_atomic_fetch_max(&lm[16 + (F.lane >> 2)], __float_as_uint(mk), __ATOMIC_RELAXED, __HIP_MEMORY_SCOPE_WORKGROUP);
                                 __hip_atomic_fetch_min(&ld[F.lane >> 2], ord_f32(md), __ATOMIC_RELAXED, __HIP_MEMORY_SCOPE_WORKGROUP); }
        __syncthreads();
        if (F.tid < 32) { const int b = ch >> 7; __hip_atomic_fetch_max(nrm + (F.tid >> 4) * 32 + b * 16 + (F.tid & 15), lm[F.tid], __ATOMIC_RELAXED, __HIP_MEMORY_SCOPE_AGENT); }
        if (F.tid < 16) { const int m = ld[F.tid]; dmin[ch * 16 + F.tid] = __int_as_float(m >= 0 ? m : m ^ 0x7fffffff); }
        __syncthreads();
    }
}
__device__ __forceinline__ void ao_quant_phase(Frame& F, const Ptrs& P) {
#pragma unroll 1
    for (int r = (F.vcu * NWAVES + F.wave) * 4; r < N_TOK; r += F.G * NWAVES * 4) {
        int ln = F.lane; asm volatile("" : "+v"(ln));
        u32x2 raw[4][8];
#pragma unroll
        for (int q = 0; q < 4; ++q)
#pragma unroll
            for (int j = 0; j < 8; ++j) raw[q][j] = ldg<u32x2>(P.AO + (size_t)(r + q) * DM, (unsigned)(64 * j + ln) * 8u);
#pragma unroll
        for (int q = 0; q < 4; ++q) { f32x4 v[8];
#pragma unroll
            for (int j = 0; j < 8; ++j) v[j] = unpack4(raw[q][j]);
            const float sc = quant_row_store(P.AO8 + (size_t)(r + q) * DM, v, ln);
            if (ln == 0) P.asc_ao[r + q] = sc; }
    }
}
__device__ __forceinline__ void hid_quant_phase(Frame& F, const Ptrs& P) {
    const int nrows = __builtin_amdgcn_readfirstlane(P.blk[0]) * 256;
#pragma unroll 1
    for (int r = (F.vcu * NWAVES + F.wave) * 4; r < nrows && r < MAX_SLOT; r += F.G * NWAVES * 4) {
        int ln = F.lane; asm volatile("" : "+v"(ln));
        u32x2 raw[4][8];
#pragma unroll
        for (int q = 0; q < 4; ++q)
#pragma unroll
            for (int j = 0; j < 8; ++j) raw[q][j] = ldg<u32x2>(P.SH + (size_t)(r + q) * DM, (unsigned)(64 * j + ln) * 8u);
#pragma unroll
        for (int q = 0; q < 4; ++q) { f32x4 v[8];
#pragma unroll
            for (int j = 0; j < 8; ++j) v[j] = unpack4(raw[q][j]);
            const float sc = quant_row_store(P.HID8 + (size_t)(r + q) * DM, v, ln);
            if (ln == 0) P.hsc[r + q] = sc * P.slot_g[r + q]; }
    }
}
__device__ __forceinline__ int load_blk_table(Frame& F, const Ptrs& P) {
    LAS int* tb = (LAS int*)(F.lds + TBL_OFF);
    if (F.tid < 16 + MAX_BLK) tb[F.tid] = P.blk[F.tid];
    __syncthreads();
    int nblk = __builtin_amdgcn_readfirstlane(tb[0]);
    return nblk > MAX_BLK ? MAX_BLK : nblk;
}

struct Args { const float* in[16]; float* out; unsigned char* ws; int ph_lo, ph_hi, li, pad; };
__device__ __forceinline__ void refresh(Frame& F) {
    int l; asm volatile("v_mbcnt_lo_u32_b32 %0, -1, 0\n\tv_mbcnt_hi_u32_b32 %0, -1, %0" : "=v"(l));
    F.lane = l; F.tid = F.wave * 64 + l;
}
__device__ __forceinline__ Ptrs mk_ptrs() {
    typedef __attribute__((address_space(4))) const Args* KA;
    KA ap = (KA)__builtin_amdgcn_kernarg_segment_ptr();
    asm volatile("" : "+s"(ap));
    Ptrs P; unsigned char* ws = ap->ws;
    P.x = ap->in[0]; P.w_qkv = ap->in[1]; P.rel_bias = ap->in[2]; P.w_ao = ap->in[3]; P.w_kv = ap->in[4]; P.fg_w = ap->in[5]; P.fg_b = ap->in[6]; P.w_bq = ap->in[7];
    P.w_bo = ap->in[8]; P.router_w = ap->in[9]; P.router_b = ap->in[10]; P.w_gate = ap->in[11]; P.w_up = ap->in[12]; P.w_down = ap->in[13]; P.ln_gain = ap->in[14]; P.ln_bias = ap->in[15];
    P.out = ap->out;
    P.Wao8 = ws + WS_WAO; P.Wbo8 = ws + WS_WBO; P.AO8 = ws + WS_XQ8; P.hmax = (float*)(ws + WS_HMAX);
    P.Wqkv8 = ws + WS_WQKV8; P.Wkvq8 = ws + WS_WKVQ8; P.Wgu8 = ws + WS_WGU8; P.Wd8 = ws + WS_WD8; P.XA8 = ws + WS_XA8; P.XQ8 = ws + WS_XQ8; P.XS8 = ws + WS_R5; P.HID8 = ws + WS_R5;
    P.SH = (bf16*)(ws + WS_R1); P.XB = (bf16*)(ws + WS_R2); P.XA = (bf16*)(ws + WS_R3); P.QKV = (bf16*)(ws + WS_R4); P.XS = (bf16*)(ws + WS_R4); P.AO = (bf16*)(ws + WS_R5);
    { unsigned char* sm = ws + WS_SMALL; P.tok_e = (int*)(sm + SM_TOKE); P.tok_g = (float*)(sm + SM_TOKG); P.slot_of = (int*)(sm + SM_SLOTOF); P.slot_g = (float*)(sm + SM_SLOTG);
      P.asc_x = (float*)(sm + SM_ASCX); P.asc_1 = (float*)(sm + SM_ASC1); P.asc_2 = (float*)(sm + SM_ASC2); P.slot_sc = (float*)(sm + SM_SLOTSC);
      P.wsc_qkv = (float*)(sm + SM_WSCQKV); P.wsc_kvq = (float*)(sm + SM_WSCKVQ); P.wsc_gu = (float*)(sm + SM_WSCGU); P.wsc_d = (float*)(sm + SM_WSCD); P.hsc = (float*)(sm + SM_HSC); P.wsc_ao = (float*)(sm + SM_WSCAO); P.wsc_bo = (float*)(sm + SM_WSCBO); P.asc_ao = (float*)(sm + SM_ASCAO);
      P.wgcnt = (int*)(sm + SM_WGCNT); P.blk = (int*)(sm + SM_BLK); P.cht = (float*)(sm + SM_CHT); P.dmin = (float*)(sm + SM_DMIN); P.floc = (float*)(sm + SM_FLOC); P.ff = (float*)(sm + SM_FF); }
    return P;
}
__global__ void __launch_bounds__(NWAVES * 64, 2) yoco_fwd(Args args) {
    extern __shared__ __attribute__((aligned(16))) unsigned char lds[];
    Frame F;
    F.lds = (LAS unsigned char*)lds;
    F.MISC = (volatile LAS unsigned*)(F.lds + MISC_OFF);
    F.tid = threadIdx.x; F.lane = F.tid & 63; F.wave = __builtin_amdgcn_readfirstlane(F.tid >> 6);
    F.G = gridDim.x; { const int bx = blockIdx.x; F.vcu = (F.G % 8 == 0) ? (bx % 8) * (F.G / 8) + bx / 8 : bx; }
    for (int u = F.tid; u < 64; u += NWAVES * 64) ((LAS unsigned*)(F.lds + MISC_OFF))[u] = 0u;
    __syncthreads();
    unsigned* const barw = (unsigned*)(args.ws + WS_CTL) + CW_BAR;
    XcdBarrier bar; bar.bar = barw; bar.x = 0; bar.st = nullptr;
    if (N_LAUNCHES == 1) bar = xcd_barrier_post(barw, F.MISC + 8, F.tid == 0);
#define GRID_BAR() do { if (N_LAUNCHES == 1) xcd_barrier(bar, F.tid == 0); } while (0)
    const int lo = args.ph_lo, hi = args.ph_hi;
#ifndef PH_MASK
#define PH_MASK 0x3fffff
#endif
#define IN(k) ((((PH_MASK) >> (k)) & 1) && lo <= (k) && (k) < hi)
#define BOTH(k) (IN(k) && IN((k) + 1))
    constexpr size_t TSTRIDE = (size_t)N_TOK * DM;
    LAS unsigned char* ring = F.lds;

    if (IN(0)) { asm volatile("; PHASE_0" ::: "memory"); refresh(F); const Ptrs P = mk_ptrs(); p0_prologue(F, P); if (BOTH(0)) GRID_BAR(); }

    if (IN(1)) { asm volatile("; PHASE_1" ::: "memory"); refresh(F); const Ptrs P = mk_ptrs();
        pg8::Gemm g{(const bf16*)P.XA8, (const bf16*)P.Wqkv8, N_TOK, 3 * DM, DM / 2}; pg8::StaticOrder S; S.init(N_TOK, 3 * DM, F.G, (int)blockIdx.x);
        pg8::EpiBf16Q E{P.QKV, DM, DM, TSTRIDE, P.asc_x, P.wsc_qkv};
        pg8::gemm_phase<pg8::EpiBf16Q, pg8::StaticOrder, true, true>(ring, g, S, E, F.tid);
        if (BOTH(1)) GRID_BAR();
    }
    if (IN(2)) { asm volatile("; PHASE_2" ::: "memory"); refresh(F); const Ptrs P = mk_ptrs();
        cv_side(F, P, 0);
        refresh(F);
        const int xq = (F.G % 8 == 0) ? (int)(blockIdx.x % 8) : 0, nq = (F.G % 8 == 0) ? 8 : 1, perq = 4096 / nq, perg = F.G / nq;
        gu32* qh = (gu32*)(args.ws + WS_CTL) + CW_QHEAD2 + 64 * xq;
        volatile LAS int* qslot = (volatile LAS int*)(F.lds + TBL_OFF + 256);
        if (F.tid == 0) qslot[0] = (int)__hip_atomic_fetch_add(qh, 1u, __ATOMIC_RELAXED, __HIP_MEMORY_SCOPE_AGENT);
        __syncthreads();
        for (;;) {
            const int n = __builtin_amdgcn_readfirstlane(qslot[0]) % (perq + perg); if (n >= perq) break;
            const int L = ((n >> 5) * nq + xq) * 32 + (n & 31), c2 = L & 127, hp = (L >> 7) & 15, b = L >> 11;
            att::Blk k; k.P0 = c2 * 128; k.j_lo = 0; k.F = nullptr; k.tab = P.rel_bias + (size_t)(hp * 2) * 257;
            k.Q = P.QKV + ((size_t)b * SEQ + k.P0) * DM + hp * 128; k.O = P.AO + ((size_t)b * SEQ + k.P0) * DM + hp * 128;
            k.K = P.QKV + TSTRIDE + (size_t)b * SEQ * DM + hp * 128; k.V = P.QKV + 2 * TSTRIDE + (size_t)b * SEQ * DM + hp * 128;
            unsigned nxt = 0u; if (F.tid == 0) nxt = __hip_atomic_fetch_add(qh, 1u, __ATOMIC_RELAXED, __HIP_MEMORY_SCOPE_AGENT);
            att::attn_block<1>(k, (char*)lds, F.tid);
            if (F.tid == 0) qslot[0] = (int)nxt;
            __syncthreads();
        }
        if (BOTH(2)) GRID_BAR();
    }
    if (IN(3)) { asm volatile("; PHASE_3" ::: "memory"); refresh(F); const Ptrs P = mk_ptrs(); ao_quant_phase(F, P); if (BOTH(3)) GRID_BAR(); }
    if (IN(4)) { asm volatile("; PHASE_4" ::: "memory"); refresh(F); const Ptrs P = mk_ptrs();
        pg8::Gemm g{(const bf16*)P.AO8, (const bf16*)P.Wao8, N_TOK, DM, DM / 2}; pg8::StaticOrder S; S.init(N_TOK, DM, F.G, (int)blockIdx.x);
        pg8::EpiResQ<true> E{P.x, P.SH, ALPHA, P.asc_ao, P.wsc_ao};
        pg8::gemm_phase<pg8::EpiResQ<true>, pg8::StaticOrder, true, true>(ring, g, S, E, F.tid);
        if (BOTH(4)) GRID_BAR();
    }
    if (IN(5)) { asm volatile("; PHASE_5" ::: "memory"); refresh(F); const Ptrs P = mk_ptrs(); ln1_route_phase(F, P, 0, P.SH, P.XB); if (BOTH(5)) GRID_BAR(); }
    if (IN(6)) { asm volatile("; PHASE_6" ::: "memory"); refresh(F); const Ptrs P = mk_ptrs(); scatter_phase(F, P); if (BOTH(6)) GRID_BAR(); }
    if (IN(7)) { asm volatile("; PHASE_7" ::: "memory"); refresh(F); const Ptrs P = mk_ptrs();
        const int nblk = load_blk_table(F, P);
        pg8::Gemm g{(const bf16*)P.XS8, (const bf16*)P.Wgu8, MAX_SLOT, 4096, DM / 2}; pg8::MoeOrder S; S.init(nblk, 4096, F.G, (int)blockIdx.x, (const LAS int*)(F.lds + TBL_OFF) + 16, (size_t)4096 * 2048);
        pg8::EpiSwiGLUQ E{P.SH, P.slot_sc, P.wsc_gu};
        pg8::gemm_phase<pg8::EpiSwiGLUQ, pg8::MoeOrder, true, true>(ring, g, S, E, F.tid);
        if (BOTH(7)) GRID_BAR();
    }
    if (IN(8)) { asm volatile("; PHASE_8" ::: "memory"); refresh(F); const Ptrs P = mk_ptrs(); hid_quant_phase(F, P); if (BOTH(8)) GRID_BAR(); }
    if (IN(9)) { asm volatile("; PHASE_9" ::: "memory"); refresh(F); const Ptrs P = mk_ptrs();
        const int nblk = load_blk_table(F, P);
        pg8::Gemm g{(const bf16*)P.HID8, (const bf16*)P.Wd8, MAX_SLOT, DM, DM / 2}; pg8::MoeOrder S; S.init(nblk, DM, F.G, (int)blockIdx.x, (const LAS int*)(F.lds + TBL_OFF) + 16, (size_t)2048 * 2048);
        pg8::EpiGateQ E{P.XS, P.hsc, P.wsc_d};
        pg8::gemm_phase<pg8::EpiGateQ, pg8::MoeOrder, true, true>(ring, g, S, E, F.tid);
        if (BOTH(9)) GRID_BAR();
    }
    if (IN(10)) { asm volatile("; PHASE_10" ::: "memory"); refresh(F); const Ptrs P = mk_ptrs(); combine_ln2_phase(F, P, 0, P.XB, nullptr, P.XA); if (BOTH(10)) GRID_BAR(); }
    if (IN(11)) { asm volatile("; PHASE_11" ::: "memory"); refresh(F); const Ptrs P = mk_ptrs();
        f_finalize(F, P);
        pg8::Gemm g{(const bf16*)P.XA8, (const bf16*)P.Wkvq8, N_TOK, 3 * DM, DM / 2}; pg8::StaticOrder S; S.init(N_TOK, 3 * DM, F.G, (int)blockIdx.x);
        pg8::EpiBf16Q E{P.QKV, DM, DM, TSTRIDE, P.asc_2, P.wsc_kvq};
        pg8::gemm_phase<pg8::EpiBf16Q, pg8::StaticOrder, true, true>(ring, g, S, E, F.tid);
        if (BOTH(11)) GRID_BAR();
    }
    if (IN(12)) { asm volatile("; PHASE_12" ::: "memory"); refresh(F); const Ptrs P = mk_ptrs();
        qk_norms(F, P.QKV + 2 * TSTRIDE, P.QKV, (gu32*)(args.ws + WS_CTL) + CW_NORM, P.dmin);
        if (BOTH(12)) GRID_BAR();
    }
    if (IN(13)) { asm volatile("; PHASE_13" ::: "memory"); refresh(F); const Ptrs P = mk_ptrs();
        cv_side(F, P, 1);
        refresh(F);
        gu32* nrm = (gu32*)(args.ws + WS_CTL) + CW_NORM; gu32* qhead = (gu32*)(args.ws + WS_CTL) + CW_QHEAD;
        volatile LAS int* qslot = (volatile LAS int*)(F.lds + TBL_OFF + 256);
        constexpr int NBLK10 = NB * 16 * 64;
        if (F.tid == 0) qslot[0] = (int)__hip_atomic_fetch_add(qhead, 1u, __ATOMIC_RELAXED, __HIP_MEMORY_SCOPE_AGENT);
        __syncthreads();
        for (;;) {
            const int n = __builtin_amdgcn_readfirstlane(qslot[0]) % (NBLK10 + F.G); if (n >= NBLK10) break;
            const int qb = 63 - (n >> 5), bh = n & 31, b = bh >> 4, h = bh & 15;
            att::Blk k; k.P0 = qb * 256; k.tab = nullptr; k.F = P.ff + (size_t)bh * SEQ;
            { const float q2 = __uint_as_float(__hip_atomic_load(nrm + bh, __ATOMIC_RELAXED, __HIP_MEMORY_SCOPE_AGENT)), k2 = __uint_as_float(__hip_atomic_load(nrm + 32 + bh, __ATOMIC_RELAXED, __HIP_MEMORY_SCOPE_AGENT));
              const int chq = b * 128 + 2 * qb;
              const float dmn = fminf(__uint_as_float(__builtin_amdgcn_readfirstlane(__float_as_uint(P.dmin[chq * 16 + h]))), __uint_as_float(__builtin_amdgcn_readfirstlane(__float_as_uint(P.dmin[(chq + 1) * 16 + h]))));
              const float thr = -(48.02f + 0.08838834764831845f * (1.001f * sqrtf(q2) * sqrtf(k2) - dmn));
              int ln = F.lane; asm volatile("" : "+v"(ln));
              const float f0 = ldg<float>(k.F + k.P0, 0u); const int C0 = k.P0 >> 6; int cnt = 0;
#pragma unroll
              for (int i = 0; i < 4; ++i) { const int j = ln + 64 * i; const bool in = j < C0; const float fj = ldg<float>(k.F, in ? (unsigned)(64 * j + 63) * 4u : 0u);
                  cnt += __builtin_popcountll(__ballot(in && (f0 - fj < thr))); }
              k.j_lo = __builtin_amdgcn_readfirstlane(cnt); }
            bf16* q = P.QKV + 2 * TSTRIDE + ((size_t)b * SEQ + k.P0) * DM + h * 128;
            k.Q = q; k.O = P.AO + ((size_t)b * SEQ + k.P0) * DM + h * 128; k.K = P.QKV + (size_t)b * SEQ * DM + h * 128; k.V = P.QKV + TSTRIDE + (size_t)b * SEQ * DM + h * 128;
            att::attn_block<0>(k, (char*)lds, F.tid);
            if (F.tid == 0) qslot[0] = (int)__hip_atomic_fetch_add(qhead, 1u, __ATOMIC_RELAXED, __HIP_MEMORY_SCOPE_AGENT);
            __syncthreads();
        }
        if (BOTH(13)) GRID_BAR();
    }
    if (IN(14)) { asm volatile("; PHASE_14" ::: "memory"); refresh(F); const Ptrs P = mk_ptrs(); ao_quant_phase(F, P); if (BOTH(14)) GRID_BAR(); }
    if (IN(15)) { asm volatile("; PHASE_15" ::: "memory"); refresh(F); const Ptrs P = mk_ptrs();
        pg8::Gemm g{(const bf16*)P.AO8, (const bf16*)P.Wbo8, N_TOK, DM, DM / 2}; pg8::StaticOrder S; S.init(N_TOK, DM, F.G, (int)blockIdx.x);
        pg8::EpiResQ<false> E{P.XA, P.SH, ALPHA, P.asc_ao, P.wsc_bo};
        pg8::gemm_phase<pg8::EpiResQ<false>, pg8::StaticOrder, true, true>(ring, g, S, E, F.tid);
        if (BOTH(15)) GRID_BAR();
    }
    if (IN(16)) { asm volatile("; PHASE_16" ::: "memory"); refresh(F); const Ptrs P = mk_ptrs(); ln1_route_phase(F, P, 1, P.SH, P.XB); if (BOTH(16)) GRID_BAR(); }
    if (IN(17)) { asm volatile("; PHASE_17" ::: "memory"); refresh(F); const Ptrs P = mk_ptrs(); scatter_phase(F, P); if (BOTH(17)) GRID_BAR(); }
    if (IN(18)) { asm volatile("; PHASE_18" ::: "memory"); refresh(F); const Ptrs P = mk_ptrs();
        const int nblk = load_blk_table(F, P);
        pg8::Gemm g{(const bf16*)(P.XS8), (const bf16*)(P.Wgu8 + (size_t)16 * 4096 * 2048), MAX_SLOT, 4096, DM / 2}; pg8::MoeOrder S; S.init(nblk, 4096, F.G, (int)blockIdx.x, (const LAS int*)(F.lds + TBL_OFF) + 16, (size_t)4096 * 2048);
        pg8::EpiSwiGLUQ E{P.SH, P.slot_sc, P.wsc_gu + (size_t)16 * 4096};
        pg8::gemm_phase<pg8::EpiSwiGLUQ, pg8::MoeOrder, true, true>(ring, g, S, E, F.tid);
        if (BOTH(18)) GRID_BAR();
    }
    if (IN(19)) { asm volatile("; PHASE_19" ::: "memory"); refresh(F); const Ptrs P = mk_ptrs(); hid_quant_phase(F, P); if (BOTH(19)) GRID_BAR(); }
    if (IN(20)) { asm volatile("; PHASE_20" ::: "memory"); refresh(F); const Ptrs P = mk_ptrs();
        const int nblk = load_blk_table(F, P);
        pg8::Gemm g{(const bf16*)P.HID8, (const bf16*)(P.Wd8 + (size_t)16 * 2048 * 2048), MAX_SLOT, DM, DM / 2}; pg8::MoeOrder S; S.init(nblk, DM, F.G, (int)blockIdx.x, (const LAS int*)(F.lds + TBL_OFF) + 16, (size_t)2048 * 2048);
        pg8::EpiGateQ E{P.XS, P.hsc, P.wsc_d + (size_t)16 * 2048};
        pg8::gemm_phase<pg8::EpiGateQ, pg8::MoeOrder, true, true>(ring, g, S, E, F.tid);
        if (BOTH(20)) GRID_BAR();
    }
    if (IN(21)) { asm volatile("; PHASE_21" ::: "memory"); refresh(F); const Ptrs P = mk_ptrs(); combine_ln2_phase(F, P, 1, P.XB, P.out, nullptr); }
#undef IN
#undef BOTH
#undef GRID_BAR
}

extern "C" void kernel_launch(void* const* d_in, const int* in_sizes, int n_in, void* d_out, int out_size, void* d_ws, size_t ws_size, hipStream_t stream) {
    static int grid = 0;
    if (grid == 0) {
        if (n_in != 16 || in_sizes[0] != N_TOK * DM || out_size != N_TOK * DM || ws_size < WS_END) { fprintf(stderr, "kernel_launch: shape mismatch (n_in %d, in0 %d, out %d, ws %zu < %zu); nothing launched\n", n_in, n_in > 0 ? in_sizes[0] : -1, out_size, ws_size, (size_t)WS_END); grid = -1; return; }
        int dev = 0, cus = 0, per_cu = 0;
        if (hipGetDevice(&dev) != hipSuccess || hipDeviceGetAttribute(&cus, hipDeviceAttributeMultiprocessorCount, dev) != hipSuccess) { fprintf(stderr, "kernel_launch: device query failed\n"); grid = -1; return; }
        if (hipFuncSetAttribute((const void*)yoco_fwd, hipFuncAttributeMaxDynamicSharedMemorySize, LDS_BYTES) != hipSuccess) { fprintf(stderr, "kernel_launch: hipFuncSetAttribute failed\n"); grid = -1; return; }
        if (hipOccupancyMaxActiveBlocksPerMultiprocessor(&per_cu, (const void*)yoco_fwd, NWAVES * 64, LDS_BYTES) != hipSuccess || per_cu < 1)
            fprintf(stderr, "kernel_launch: note: occupancy query reports %d workgroups per CU\n", per_cu);
        (void)hipGetLastError();
        grid = cus;
    }
    if (grid < 0) return;
    if (hipMemsetAsync((char*)d_ws + WS_CTL, 0, CTL_ZERO_BYTES, stream) != hipSuccess) { fprintf(stderr, "kernel_launch: memset failed\n"); return; }
    Args a{};
    for (int i = 0; i < 16; ++i) a.in[i] = (const float*)d_in[i];
    a.out = (float*)d_out; a.ws = (unsigned char*)d_ws;
#ifndef DUP_MASK
#define DUP_MASK 0
#endif
    for (int li = 0; li < N_LAUNCHES; ++li) {
        a.ph_lo = (N_LAUNCHES == 1) ? 0 : li; a.ph_hi = (N_LAUNCHES == 1) ? N_PHASES : li + 1; a.li = li; a.pad = 0;
#ifndef PROBE_KSHIFT
#define PROBE_KSHIFT 0
#endif
        if (N_LAUNCHES != 1 && (((DUP_MASK) >> li) & 1)) { a.pad = PROBE_KSHIFT; hipLaunchKernelGGL(yoco_fwd, dim3(grid), dim3(NWAVES * 64), LDS_BYTES, stream, a); a.pad = 0; }
        hipLaunchKernelGGL(yoco_fwd, dim3(grid), dim3(NWAVES * 64), LDS_BYTES, stream, a);
        const hipError_t le = hipPeekAtLastError();
        if (le != hipSuccess) { fprintf(stderr, "kernel_launch: launch %d failed: %s\n", li, hipGetErrorName(le)); break; }
    }
}
```

```cpp
#include <hip/hip_runtime.h>
#include <cstdio>
#include <cstdint>
#ifndef MK_N_LAUNCHES
#define MK_N_LAUNCHES 1
#endif
namespace pg8 {
#define PG8_LAS __attribute__((address_space(3)))
typedef unsigned short bf16_t;
typedef short bf16x8 __attribute__((ext_vector_type(8)));
typedef float f32x4 __attribute__((ext_vector_type(4)));
typedef unsigned u32x4 __attribute__((ext_vector_type(4)));
constexpr int BM = 256, BK = 64, HALF = 128, HTB = HALF * BK * 2  , STAGE_BYTES = 8 * HTB, NXCD = 8, WGM = 8;

__host__ __device__ __forceinline__ int lds_byte(int r, int c) { const int st = (r >> 4) * 2 + (c >> 5), rr = r & 15, cc = c & 31, ob = rr * 64 + cc * 2; return st * 1024 + (ob ^ (((ob >> 9) & 1) << 5)); }
__host__ __device__ __forceinline__ void stage_rc(int b, int& R, int& C) { const int st = b / 1024, sb = b % 1024, swz = sb ^ (((sb >> 9) & 1) << 5); R = (st >> 1) * 16 + swz / 64; C = (st & 1) * 32 + (swz % 64) / 2; }
__host__ __device__ __forceinline__ int perm32(int rho) { const int n = rho >> 4, i = rho & 15; return 8 * (i >> 2) + 4 * n + (i & 3); }

struct Unit { int pm, pn, ex; size_t boff; };
struct Gemm { const bf16_t* A; const bf16_t* Bt; int M, N, K; };

struct StaticOrder {
    int nM, nN, nwg, G, c;
    __host__ __device__ void init(int M, int N, int G_, int c_) { nM = M / BM; nN = N / BM; nwg = nM * nN; G = G_; c = c_; }
    __host__ __device__ bool next(int i, Unit& u) const {
        const long L = (long)i * G + c; if (L >= nwg) return false;
        int wgid = (int)L; { const int q = nwg / NXCD, r = nwg % NXCD, xcd = wgid % NXCD, off = wgid / NXCD; wgid = (xcd < r ? xcd * (q + 1) : r * (q + 1) + (xcd - r) * q) + off; }
        const int nig = WGM * nN, gid = wgid / nig, fm = gid * WGM, gsz = (nM - fm) < WGM ? (nM - fm) : WGM;
        u.pm = fm + ((wgid % nig) % gsz); u.pn = (wgid % nig) / gsz; u.ex = 0; u.boff = 0; return true;
    }
    __device__ __forceinline__ void a_ready(const Unit&) const {}
    __device__ __forceinline__ void done(const Unit&) const {}
};

__device__ __forceinline__ unsigned cvt_pk_bf16(float lo, float hi) { unsigned r; asm volatile("v_cvt_pk_bf16_f32 %0, %1, %2" : "=v"(r) : "v"(lo), "v"(hi)); return r; }
typedef float f32x2 __attribute__((ext_vector_type(2)));
__device__ __forceinline__ f32x2 gelu_pk(f32x2 v) {
    const f32x2 av = __builtin_elementwise_abs(v), d = av * 0.2316418882f + 1.0f;
    f32x2 t; t.x = __builtin_amdgcn_rcpf(d.x); t.y = __builtin_amdgcn_rcpf(d.y);
    f32x2 q = t * 0.5307027145f + (-0.7265760135f); q = q * t + 0.7107068705f; q = q * t + (-0.142248368f); q = q * t + 0.127414796f; q = q * t;
    const f32x2 s = (v * v) * (-0.72134752044f);
    f32x2 e; e.x = __builtin_amdgcn_exp2f(s.x); e.y = __builtin_amdgcn_exp2f(s.y);
    const f32x2 m = v * (q * e), r = v - m;
    f32x2 o; o.x = v.x < 0.f ? m.x : r.x; o.y = v.y < 0.f ? m.y : r.y; return o;
}

template <int ACT  > struct EpiBf16 {
    static constexpr bool PERM = true, AFTER_DRAIN = false, I8 = false; static_assert(ACT == 0 || ACT == 1, "EpiBf16: ACT is 0 (none) or 1 (gelu_pk)");
    bf16_t* O; int ldc; const float* bias; int split_cols; size_t split_stride; float scale0;
    __device__ __forceinline__ void operator()(const f32x4 (&acc)[2][2][4][2], const Unit& u, int wr, int wc, int fr, int fq) const {
        const int row0 = u.pm * BM + wr * 64 + fr; int colt = u.pn * BM; bf16_t* base = O;
        float sc = 1.f; if (split_cols) { const int t = colt / split_cols; base += (size_t)t * split_stride; colt -= t * split_cols; if (t == 0) sc = scale0; }
        const int col0 = colt + wc * 32 + 8 * fq, bcol0 = u.pn * BM + wc * 32 + 8 * fq;
        f32x4 bv[2][2];
#pragma unroll
        for (int bj = 0; bj < 2; ++bj)
#pragma unroll
            for (int n = 0; n < 2; ++n) bv[bj][n] = bias ? *(const f32x4*)(bias + bcol0 + bj * HALF + 4 * n) : (f32x4){0.f, 0.f, 0.f, 0.f};
#pragma unroll
        for (int ai = 0; ai < 2; ++ai)
#pragma unroll
            for (int m = 0; m < 4; ++m) { bf16_t* rowp = base + (size_t)(row0 + ai * HALF + m * 16) * ldc + col0;
#pragma unroll
                for (int bj = 0; bj < 2; ++bj) { f32x4 v0 = acc[ai][bj][m][0] + bv[bj][0], v1 = acc[ai][bj][m][1] + bv[bj][1];
                    if (ACT == 1) { f32x2 a = gelu_pk((f32x2){v0[0], v0[1]}), b = gelu_pk((f32x2){v0[2], v0[3]}), c = gelu_pk((f32x2){v1[0], v1[1]}), d = gelu_pk((f32x2){v1[2], v1[3]});
                        v0 = (f32x4){a.x, a.y, b.x, b.y}; v1 = (f32x4){c.x, c.y, d.x, d.y}; }
                    v0 = v0 * sc; v1 = v1 * sc; u32x4 w; w.x = cvt_pk_bf16(v0[0], v0[1]); w.y = cvt_pk_bf16(v0[2], v0[3]); w.z = cvt_pk_bf16(v1[0], v1[1]); w.w = cvt_pk_bf16(v1[2], v1[3]);
                    *(u32x4*)(rowp + bj * HALF) = w; } }
    }
};
typedef int i32x4 __attribute__((ext_vector_type(4)));
template <bool I8> struct AccOf { typedef f32x4 type; };
template <> struct AccOf<true> { typedef i32x4 type; };
__device__ __forceinline__ f32x4 mma16(bf16x8 b, bf16x8 a, f32x4 c) { return __builtin_amdgcn_mfma_f32_16x16x32_bf16(b, a, c, 0, 0, 0); }
__device__ __forceinline__ i32x4 mma16(bf16x8 b, bf16x8 a, i32x4 c) { return __builtin_amdgcn_mfma_i32_16x16x64_i8(__builtin_bit_cast(i32x4, b), __builtin_bit_cast(i32x4, a), c, 0, 0, 0); }
__device__ __forceinline__ f32x4 cvt4(i32x4 v) { return __builtin_convertvector(v, f32x4); }
constexpr int SCL_OFF = 131072 + 2048;
template <class E, class = void> struct ScalesLds { static constexpr bool value = false; };
template <class E> struct ScalesLds<E, decltype((void)E::SCALES_LDS)> { static constexpr bool value = E::SCALES_LDS; };
struct EpiBf16Q {
    static constexpr bool PERM = true, AFTER_DRAIN = false, I8 = true;
    bf16_t* O; int ldc; int split_cols; size_t split_stride; const float* sa; const float* sw;
    static constexpr bool SCALES_LDS = true;
    __device__ __forceinline__ const float* row_scales(const Unit& u) const { return sa + u.pm * BM; }
    __device__ __forceinline__ const float* col_scales(const Unit& u) const { return sw + u.pn * BM; }
    __device__ __forceinline__ void operator()(const i32x4 (&acc)[2][2][4][2], const Unit& u, int wr, int wc, int fr, int fq, const PG8_LAS float* sc) const {
        const int row0 = u.pm * BM + wr * 64 + fr; int colt = u.pn * BM; bf16_t* base = O;
        { const int t = colt / split_cols; base += (size_t)t * split_stride; colt -= t * split_cols; }
        const int col0 = colt + wc * 32 + 8 * fq;
        f32x4 wv[2][2];
#pragma unroll
        for (int bj = 0; bj < 2; ++bj)
#pragma unroll
            for (int n = 0; n < 2; ++n) wv[bj][n] = *(const PG8_LAS f32x4*)(sc + 256 + wc * 32 + 8 * fq + bj * HALF + 4 * n);
        float a8[2][4];
#pragma unroll
        for (int ai = 0; ai < 2; ++ai)
#pragma unroll
            for (int m = 0; m < 4; ++m) a8[ai][m] = sc[wr * 64 + fr + ai * HALF + m * 16];
        asm volatile("" ::: "memory");
#pragma unroll
        for (int ai = 0; ai < 2; ++ai)
#pragma unroll
            for (int m = 0; m < 4; ++m) { const int r = row0 + ai * HALF + m * 16; const float a = a8[ai][m]; bf16_t* rowp = base + (size_t)r * ldc + col0;
#pragma unroll
                for (int bj = 0; bj < 2; ++bj) { const f32x4 v0 = cvt4(acc[ai][bj][m][0]) * a * wv[bj][0], v1 = cvt4(acc[ai][bj][m][1]) * a * wv[bj][1];
                    u32x4 w; w.x = cvt_pk_bf16(v0[0], v0[1]); w.y = cvt_pk_bf16(v0[2], v0[3]); w.z = cvt_pk_bf16(v1[0], v1[1]); w.w = cvt_pk_bf16(v1[2], v1[3]);
                    *(u32x4*)(rowp + bj * HALF) = w; } }
    }
};
template <bool RES32> struct EpiResQ {
    static constexpr bool PERM = true, AFTER_DRAIN = false, I8 = true;
    const void* res; bf16_t* out; float alpha; const float* sa; const float* sw;
    __device__ __forceinline__ void operator()(const i32x4 (&acc)[2][2][4][2], const Unit& u, int wr, int wc, int fr, int fq) const {
        const int col0 = u.pn * BM + wc * 32 + 8 * fq, row0 = u.pm * BM + wr * 64 + fr;
        const size_t rbase = (size_t)row0 * 2048 + col0;
        f32x4 wv[2][2]; float a8[2][4];
#pragma unroll
        for (int bj = 0; bj < 2; ++bj)
#pragma unroll
            for (int n = 0; n < 2; ++n) wv[bj][n] = *(const f32x4*)(sw + col0 + bj * HALF + 4 * n);
#pragma unroll
        for (int ai = 0; ai < 2; ++ai)
#pragma unroll
            for (int m = 0; m < 4; ++m) a8[ai][m] = sa[row0 + ai * HALF + m * 16];
        if constexpr (!RES32) {
            u32x4 rr[2][4][2];
#pragma unroll
            for (int ai = 0; ai < 2; ++ai)
#pragma unroll
                for (int m = 0; m < 4; ++m)
#pragma unroll
                    for (int bj = 0; bj < 2; ++bj) rr[ai][m][bj] = *(const u32x4*)((const bf16_t*)res + rbase + (size_t)(ai * HALF + m * 16) * 2048 + bj * HALF);
            asm volatile("" ::: "memory");
#pragma unroll
            for (int ai = 0; ai < 2; ++ai)
#pragma unroll
                for (int m = 0; m < 4; ++m)
#pragma unroll
                    for (int bj = 0; bj < 2; ++bj) { const u32x4 r = rr[ai][m][bj]; const float a = a8[ai][m];
                        const f32x4 x0 = (f32x4){__uint_as_float(r.x << 16), __uint_as_float(r.x & 0xffff0000u), __uint_as_float(r.y << 16), __uint_as_float(r.y & 0xffff0000u)};
                        const f32x4 x1 = (f32x4){__uint_as_float(r.z << 16), __uint_as_float(r.z & 0xffff0000u), __uint_as_float(r.w << 16), __uint_as_float(r.w & 0xffff0000u)};
                        const f32x4 v0 = x0 * alpha + cvt4(acc[ai][bj][m][0]) * a * wv[bj][0], v1 = x1 * alpha + cvt4(acc[ai][bj][m][1]) * a * wv[bj][1];
                        u32x4 w; w.x = cvt_pk_bf16(v0[0], v0[1]); w.y = cvt_pk_bf16(v0[2], v0[3]); w.z = cvt_pk_bf16(v1[0], v1[1]); w.w = cvt_pk_bf16(v1[2], v1[3]);
                        *(u32x4*)(out + rbase + (size_t)(ai * HALF + m * 16) * 2048 + bj * HALF) = w; }
        } else {
            f32x4 xa[4][2][2]; u32x4 wo[4][2];
#pragma unroll
            for (int m = 0; m < 4; ++m)
#pragma unroll
                for (int bj = 0; bj < 2; ++bj) { const float* p = (const float*)res + rbase + (size_t)(m * 16) * 2048 + bj * HALF; xa[m][bj][0] = *(const f32x4*)p; xa[m][bj][1] = *(const f32x4*)(p + 4); }
            asm volatile("" ::: "memory");
#pragma unroll
            for (int m = 0; m < 4; ++m)
#pragma unroll
                for (int bj = 0; bj < 2; ++bj) { const float a = a8[0][m]; const f32x4 v0 = xa[m][bj][0] * alpha + cvt4(acc[0][bj][m][0]) * a * wv[bj][0], v1 = xa[m][bj][1] * alpha + cvt4(acc[0][bj][m][1]) * a * wv[bj][1];
                    wo[m][bj].x = cvt_pk_bf16(v0[0], v0[1]); wo[m][bj].y = cvt_pk_bf16(v0[2], v0[3]); wo[m][bj].z = cvt_pk_bf16(v1[0], v1[1]); wo[m][bj].w = cvt_pk_bf16(v1[2], v1[3]); }
            asm volatile("" : "+v"(wo[0][0]), "+v"(wo[0][1]), "+v"(wo[1][0]), "+v"(wo[1][1]), "+v"(wo[2][0]), "+v"(wo[2][1]), "+v"(wo[3][0]), "+v"(wo[3][1]));
#pragma unroll
            for (int m = 0; m < 4; ++m)
#pragma unroll
                for (int bj = 0; bj < 2; ++bj) { const float* p = (const float*)res + rbase + (size_t)(HALF + m * 16) * 2048 + bj * HALF; xa[m][bj][0] = *(const f32x4*)p; xa[m][bj][1] = *(const f32x4*)(p + 4); }
            asm volatile("" ::: "memory");
#pragma unroll
            for (int m = 0; m < 4; ++m)
#pragma unroll
                for (int bj = 0; bj < 2; ++bj) *(u32x4*)(out + rbase + (size_t)(m * 16) * 2048 + bj * HALF) = wo[m][bj];
#pragma unroll
            for (int m = 0; m < 4; ++m)
#pragma unroll
                for (int bj = 0; bj < 2; ++bj) { const float a = a8[1][m]; const f32x4 v0 = xa[m][bj][0] * alpha + cvt4(acc[1][bj][m][0]) * a * wv[bj][0], v1 = xa[m][bj][1] * alpha + cvt4(acc[1][bj][m][1]) * a * wv[bj][1];
                    u32x4 w; w.x = cvt_pk_bf16(v0[0], v0[1]); w.y = cvt_pk_bf16(v0[2], v0[3]); w.z = cvt_pk_bf16(v1[0], v1[1]); w.w = cvt_pk_bf16(v1[2], v1[3]);
                    *(u32x4*)(out + rbase + (size_t)(HALF + m * 16) * 2048 + bj * HALF) = w; }
        }
    }
};
struct EpiSwiGLUQ {
    static constexpr bool PERM = true, AFTER_DRAIN = false, I8 = true;
    bf16_t* H; const float* sa; const float* sw;
    __device__ __forceinline__ static float swi(float g, float u) { const float e = __builtin_amdgcn_exp2f(g * -1.4426950408889634f); return g * __builtin_amdgcn_rcpf(1.0f + e) * u; }
    static constexpr bool SCALES_LDS = true;
    __device__ __forceinline__ const float* row_scales(const Unit& u) const { return sa + u.pm * BM; }
    __device__ __forceinline__ const float* col_scales(const Unit& u) const { return sw + (size_t)u.ex * 4096 + u.pn * BM; }
    __device__ __forceinline__ void operator()(const i32x4 (&acc)[2][2][4][2], const Unit& u, int wr, int wc, int fr, int fq, const PG8_LAS float* sc) const {
        const int row0 = u.pm * BM + wr * 64 + fr, col0 = u.pn * HALF + wc * 32 + 8 * fq;
        const PG8_LAS float* swe = sc + 256 + wc * 32 + 8 * fq;
        const f32x4 wg0 = *(const PG8_LAS f32x4*)swe, wg1 = *(const PG8_LAS f32x4*)(swe + 4), wu0 = *(const PG8_LAS f32x4*)(swe + HALF), wu1 = *(const PG8_LAS f32x4*)(swe + HALF + 4);
        float a8[2][4];
#pragma unroll
        for (int ai = 0; ai < 2; ++ai)
#pragma unroll
            for (int m = 0; m < 4; ++m) a8[ai][m] = sc[wr * 64 + fr + ai * HALF + m * 16];
        asm volatile("" ::: "memory");
#pragma unroll
        for (int ai = 0; ai < 2; ++ai)
#pragma unroll
            for (int m = 0; m < 4; ++m) { const int r = row0 + ai * HALF + m * 16; const float a = a8[ai][m]; bf16_t* rowp = H + (size_t)r * 2048 + col0;
                const f32x4 g0 = cvt4(acc[ai][0][m][0]) * a * wg0, g1 = cvt4(acc[ai][0][m][1]) * a * wg1, u0 = cvt4(acc[ai][1][m][0]) * a * wu0, u1 = cvt4(acc[ai][1][m][1]) * a * wu1;
                const float h0 = swi(g0[0], u0[0]), h1 = swi(g0[1], u0[1]), h2 = swi(g0[2], u0[2]), h3 = swi(g0[3], u0[3]), h4 = swi(g1[0], u1[0]), h5 = swi(g1[1], u1[1]), h6 = swi(g1[2], u1[2]), h7 = swi(g1[3], u1[3]);
                u32x4 w; w.x = cvt_pk_bf16(h0, h1); w.y = cvt_pk_bf16(h2, h3); w.z = cvt_pk_bf16(h4, h5); w.w = cvt_pk_bf16(h6, h7);
                *(u32x4*)rowp = w; }
    }
};
struct EpiGateQ {
    static constexpr bool PERM = true, AFTER_DRAIN = false, I8 = true;
    bf16_t* Y; const float* sa; const float* sw;
    static constexpr bool SCALES_LDS = true;
    __device__ __forceinline__ const float* row_scales(const Unit& u) const { return sa + u.pm * BM; }
    __device__ __forceinline__ const float* col_scales(const Unit& u) const { return sw + (size_t)u.ex * 2048 + u.pn * BM; }
    __device__ __forceinline__ void operator()(const i32x4 (&acc)[2][2][4][2], const Unit& u, int wr, int wc, int fr, int fq, const PG8_LAS float* sc) const {
        const int row0 = u.pm * BM + wr * 64 + fr, col0 = u.pn * BM + wc * 32 + 8 * fq;
        const PG8_LAS float* swe = sc + 256 + wc * 32 + 8 * fq;
        f32x4 wv[2][2];
#pragma unroll
        for (int bj = 0; bj < 2; ++bj)
#pragma unroll
            for (int n = 0; n < 2; ++n) wv[bj][n] = *(const PG8_LAS f32x4*)(swe + bj * HALF + 4 * n);
        float g8[2][4];
#pragma unroll
        for (int ai = 0; ai < 2; ++ai)
#pragma unroll
            for (int m = 0; m < 4; ++m) g8[ai][m] = sc[wr * 64 + fr + ai * HALF + m * 16];
        asm volatile("" ::: "memory");
#pragma unroll
        for (int ai = 0; ai < 2; ++ai)
#pragma unroll
            for (int m = 0; m < 4; ++m) { const int r = row0 + ai * HALF + m * 16; const float gt = g8[ai][m]; bf16_t* rowp = Y + (size_t)r * 2048 + col0;
#pragma unroll
                for (int bj = 0; bj < 2; ++bj) { const f32x4 v0 = cvt4(acc[ai][bj][m][0]) * gt * wv[bj][0], v1 = cvt4(acc[ai][bj][m][1]) * gt * wv[bj][1];
                    u32x4 w; w.x = cvt_pk_bf16(v0[0], v0[1]); w.y = cvt_pk_bf16(v0[2], v0[3]); w.z = cvt_pk_bf16(v1[0], v1[1]); w.w = cvt_pk_bf16(v1[2], v1[3]);
                    *(u32x4*)(rowp + bj * HALF) = w; } }
    }
};
template <bool RES32> struct EpiResBf16 {
    static constexpr bool PERM = true, AFTER_DRAIN = false, I8 = false;
    const void* res; bf16_t* out; float alpha;
    __device__ __forceinline__ void operator()(const f32x4 (&acc)[2][2][4][2], const Unit& u, int wr, int wc, int fr, int fq) const {
        const int col0 = u.pn * BM + wc * 32 + 8 * fq;
        const size_t rbase = (size_t)(u.pm * BM + wr * 64 + fr) * 2048 + col0;
        if constexpr (!RES32) {
            u32x4 rr[2][4][2];
#pragma unroll
            for (int ai = 0; ai < 2; ++ai)
#pragma unroll
                for (int m = 0; m < 4; ++m)
#pragma unroll
                    for (int bj = 0; bj < 2; ++bj) rr[ai][m][bj] = *(const u32x4*)((const bf16_t*)res + rbase + (size_t)(ai * HALF + m * 16) * 2048 + bj * HALF);
            asm volatile("" ::: "memory");
#pragma unroll
            for (int ai = 0; ai < 2; ++ai)
#pragma unroll
                for (int m = 0; m < 4; ++m)
#pragma unroll
                    for (int bj = 0; bj < 2; ++bj) { const u32x4 r = rr[ai][m][bj];
                        const f32x4 x0 = (f32x4){__uint_as_float(r.x << 16), __uint_as_float(r.x & 0xffff0000u), __uint_as_float(r.y << 16), __uint_as_float(r.y & 0xffff0000u)};
                        const f32x4 x1 = (f32x4){__uint_as_float(r.z << 16), __uint_as_float(r.z & 0xffff0000u), __uint_as_float(r.w << 16), __uint_as_float(r.w & 0xffff0000u)};
                        const f32x4 v0 = x0 * alpha + acc[ai][bj][m][0], v1 = x1 * alpha + acc[ai][bj][m][1];
                        u32x4 w; w.x = cvt_pk_bf16(v0[0], v0[1]); w.y = cvt_pk_bf16(v0[2], v0[3]); w.z = cvt_pk_bf16(v1[0], v1[1]); w.w = cvt_pk_bf16(v1[2], v1[3]);
                        *(u32x4*)(out + rbase + (size_t)(ai * HALF + m * 16) * 2048 + bj * HALF) = w; }
        } else {
            f32x4 xa[4][2][2]; u32x4 wo[4][2];
#pragma unroll
            for (int m = 0; m < 4; ++m)
#pragma unroll
                for (int bj = 0; bj < 2; ++bj) { const float* p = (const float*)res + rbase + (size_t)(m * 16) * 2048 + bj * HALF; xa[m][bj][0] = *(const f32x4*)p; xa[m][bj][1] = *(const f32x4*)(p + 4); }
            asm volatile("" ::: "memory");
#pragma unroll
            for (int m = 0; m < 4; ++m)
#pragma unroll
                for (int bj = 0; bj < 2; ++bj) { const f32x4 v0 = xa[m][bj][0] * alpha + acc[0][bj][m][0], v1 = xa[m][bj][1] * alpha + acc[0][bj][m][1];
                    wo[m][bj].x = cvt_pk_bf16(v0[0], v0[1]); wo[m][bj].y = cvt_pk_bf16(v0[2], v0[3]); wo[m][bj].z = cvt_pk_bf16(v1[0], v1[1]); wo[m][bj].w = cvt_pk_bf16(v1[2], v1[3]); }
            asm volatile("" : "+v"(wo[0][0]), "+v"(wo[0][1]), "+v"(wo[1][0]), "+v"(wo[1][1]), "+v"(wo[2][0]), "+v"(wo[2][1]), "+v"(wo[3][0]), "+v"(wo[3][1]));
#pragma unroll
            for (int m = 0; m < 4; ++m)
#pragma unroll
                for (int bj = 0; bj < 2; ++bj) { const float* p = (const float*)res + rbase + (size_t)(HALF + m * 16) * 2048 + bj * HALF; xa[m][bj][0] = *(const f32x4*)p; xa[m][bj][1] = *(const f32x4*)(p + 4); }
            asm volatile("" ::: "memory");
#pragma unroll
            for (int m = 0; m < 4; ++m)
#pragma unroll
                for (int bj = 0; bj < 2; ++bj) *(u32x4*)(out + rbase + (size_t)(m * 16) * 2048 + bj * HALF) = wo[m][bj];
#pragma unroll
            for (int m = 0; m < 4; ++m)
#pragma unroll
                for (int bj = 0; bj < 2; ++bj) { const f32x4 v0 = xa[m][bj][0] * alpha + acc[1][bj][m][0], v1 = xa[m][bj][1] * alpha + acc[1][bj][m][1];
                    u32x4 w; w.x = cvt_pk_bf16(v0[0], v0[1]); w.y = cvt_pk_bf16(v0[2], v0[3]); w.z = cvt_pk_bf16(v1[0], v1[1]); w.w = cvt_pk_bf16(v1[2], v1[3]);
                    *(u32x4*)(out + rbase + (size_t)(HALF + m * 16) * 2048 + bj * HALF) = w; }
        }
    }
};
struct EpiSwiGLU {
    static constexpr bool PERM = true, AFTER_DRAIN = false, I8 = false;
    bf16_t* H;
    __device__ __forceinline__ static float swi(float g, float u) { const float e = __builtin_amdgcn_exp2f(g * -1.4426950408889634f); return g * __builtin_amdgcn_rcpf(1.0f + e) * u; }
    __device__ __forceinline__ void operator()(const f32x4 (&acc)[2][2][4][2], const Unit& u, int wr, int wc, int fr, int fq) const {
        const int row0 = u.pm * BM + wr * 64 + fr, col0 = u.pn * HALF + wc * 32 + 8 * fq;
#pragma unroll
        for (int ai = 0; ai < 2; ++ai)
#pragma unroll
            for (int m = 0; m < 4; ++m) { bf16_t* rowp = H + (size_t)(row0 + ai * HALF + m * 16) * 2048 + col0;
                const f32x4 g0 = acc[ai][0][m][0], g1 = acc[ai][0][m][1], u0 = acc[ai][1][m][0], u1 = acc[ai][1][m][1];
                u32x4 w; w.x = cvt_pk_bf16(swi(g0[0], u0[0]), swi(g0[1], u0[1])); w.y = cvt_pk_bf16(swi(g0[2], u0[2]), swi(g0[3], u0[3]));
                w.z = cvt_pk_bf16(swi(g1[0], u1[0]), swi(g1[1], u1[1])); w.w = cvt_pk_bf16(swi(g1[2], u1[2]), swi(g1[3], u1[3]));
                *(u32x4*)rowp = w; }
    }
};
struct EpiGateBf16 {
    static constexpr bool PERM = true, AFTER_DRAIN = false, I8 = false;
    bf16_t* Y; const float* gate;
    __device__ __forceinline__ void operator()(const f32x4 (&acc)[2][2][4][2], const Unit& u, int wr, int wc, int fr, int fq) const {
        const int row0 = u.pm * BM + wr * 64 + fr, col0 = u.pn * BM + wc * 32 + 8 * fq;
#pragma unroll
        for (int ai = 0; ai < 2; ++ai)
#pragma unroll
            for (int m = 0; m < 4; ++m) { const int r = row0 + ai * HALF + m * 16; const float gt = gate[r]; bf16_t* rowp = Y + (size_t)r * 2048 + col0;
#pragma unroll
                for (int bj = 0; bj < 2; ++bj) { const f32x4 v0 = acc[ai][bj][m][0] * gt, v1 = acc[ai][bj][m][1] * gt;
                    u32x4 w; w.x = cvt_pk_bf16(v0[0], v0[1]); w.y = cvt_pk_bf16(v0[2], v0[3]); w.z = cvt_pk_bf16(v1[0], v1[1]); w.w = cvt_pk_bf16(v1[2], v1[3]);
                    *(u32x4*)(rowp + bj * HALF) = w; } }
    }
};
struct MoeOrder {
    int nM, nN, nwg, G, c; const PG8_LAS int* blk_exp; size_t estride;
    __device__ __forceinline__ void init(int nblk, int N, int G_, int c_, const PG8_LAS int* be, size_t es) { nM = nblk; nN = N / BM; nwg = nM * nN; G = G_; c = c_; blk_exp = be; estride = es; }
    __device__ __forceinline__ bool next(int i, Unit& u) const {
        const long L = (long)i * G + c; if (L >= nwg) return false;
        int wgid = (int)L; { const int q = nwg / NXCD, r = nwg % NXCD, xcd = wgid % NXCD, off = wgid / NXCD; wgid = (xcd < r ? xcd * (q + 1) : r * (q + 1) + (xcd - r) * q) + off; }
        const int nig = WGM * nN, gid = wgid / nig, fm = gid * WGM, gsz = (nM - fm) < WGM ? (nM - fm) : WGM;
        u.pm = fm + ((wgid % nig) % gsz); u.pn = (wgid % nig) / gsz;
        u.ex = __builtin_amdgcn_readfirstlane(blk_exp[u.pm]); u.boff = (size_t)u.ex * estride; return true;
    }
    __device__ __forceinline__ void a_ready(const Unit&) const {}
    __device__ __forceinline__ void done(const Unit&) const {}
};
template <class Epi, class Sched, bool ALIGN_EPI = false, bool SP2 = false>
__device__ __forceinline__ void gemm_phase(PG8_LAS unsigned char* lds, const Gemm g, const Sched& S, const Epi& E, const int tid) {
    const int wid = __builtin_amdgcn_readfirstlane(tid >> 6), lane = tid & 63, wr = wid >> 2, wc = wid & 3, fr = lane & 15, fq = lane >> 4;
    const int K = g.K, nt = K / BK;
    unsigned voffA[2], voffB[2];
#pragma unroll
    for (int i = 0; i < 2; ++i) { int R, C; stage_rc(tid * 16 + i * 8192, R, C); const int Rb = Epi::PERM ? ((R & ~31) + perm32(R & 31)) : R;
        voffA[i] = (unsigned)(R * K + C) * 2u; voffB[i] = (unsigned)(Rb * K + C) * 2u; }
    const size_t kstep = (size_t)(BK * 2);
    const size_t hstep = (size_t)HALF * K * 2;
    const size_t tstep = 2 * hstep;
    const unsigned ldsw = (unsigned)wid * 1024u;
    const int aoff = lds_byte(wr * 64 + fr, fq * 8), boff = lds_byte(wc * 32 + fr, fq * 8);
#define PG8_SA(b, h) (((b) * 2 + (h)) * HTB)
#define PG8_SB(b, h) ((4 + (b) * 2 + (h)) * HTB)
#define PG8_STAGE(bufoff, gbase, voff) do { _Pragma("unroll") for (int _i = 0; _i < 2; ++_i) \
        __builtin_amdgcn_global_load_lds((const unsigned*)((const char*)(gbase) + (voff)[_i]), (PG8_LAS unsigned*)(lds + (bufoff) + ldsw + _i * 8192), 16, 0, 0); } while (0)
#define PG8_LDA(dst, b, h) do { _Pragma("unroll") for (int m = 0; m < 4; ++m) _Pragma("unroll") for (int k = 0; k < 2; ++k) dst[m][k] = *(const PG8_LAS bf16x8*)(lds + PG8_SA(b, h) + aoff + m * 2048 + k * 1024); } while (0)
#define PG8_LDB(dst, b, h) do { _Pragma("unroll") for (int n = 0; n < 2; ++n) _Pragma("unroll") for (int k = 0; k < 2; ++k) dst[n][k] = *(const PG8_LAS bf16x8*)(lds + PG8_SB(b, h) + boff + n * 2048 + k * 1024); } while (0)
#define PG8_MMA(ai, bj, At, Bt) do { __builtin_amdgcn_s_setprio(1); _Pragma("unroll") for (int m = 0; m < 4; ++m) _Pragma("unroll") for (int n = 0; n < 2; ++n) _Pragma("unroll") for (int k = 0; k < 2; ++k) \
        acc[ai][bj][m][n] = mma16(Bt[n][k], At[m][k], acc[ai][bj][m][n]); __builtin_amdgcn_s_setprio(0); } while (0)
#define PG8_WAIT_V(n) asm volatile("s_waitcnt vmcnt(" #n ")" ::: "memory")
#define PG8_WAIT_L(n) asm volatile("s_waitcnt lgkmcnt(" #n ")" ::: "memory")
#define PG8_BAR __builtin_amdgcn_s_barrier()
#define PG8_SCHED __builtin_amdgcn_sched_barrier(0)
    Unit cur, nxt; int ui = 0;
    if (!S.next(0, cur)) return;
    typedef typename AccOf<Epi::I8>::type acc_t;
    acc_t acc[2][2][4][2];
#pragma unroll
    for (int a = 0; a < 2; ++a)
#pragma unroll
        for (int b = 0; b < 2; ++b)
#pragma unroll
            for (int m = 0; m < 4; ++m)
#pragma unroll
                for (int n = 0; n < 2; ++n) acc[a][b][m][n] = acc_t{};
    bf16x8 At[4][2], B0[2][2], B1[2][2];
    const char* cA = (const char*)g.A + (size_t)cur.pm * tstep; const char* cB = (const char*)g.Bt + cur.boff + (size_t)cur.pn * tstep;
    S.a_ready(cur);
    if constexpr (SP2) {
        PG8_STAGE(PG8_SB(0, 0), cB, voffB); PG8_STAGE(PG8_SB(0, 1), cB + hstep, voffB); PG8_STAGE(PG8_SA(0, 0), cA, voffA); PG8_STAGE(PG8_SA(0, 1), cA + hstep, voffA);
        if (wr == 1) PG8_BAR;
        PG8_WAIT_V(2); PG8_BAR;
        PG8_STAGE(PG8_SB(1, 0), cB + kstep, voffB); PG8_STAGE(PG8_SA(1, 0), cA + kstep, voffA); PG8_STAGE(PG8_SB(1, 1), cB + hstep + kstep, voffB);
        PG8_WAIT_V(6); PG8_BAR;
    } else {
        PG8_STAGE(PG8_SB(0, 0), cB, voffB); PG8_STAGE(PG8_SA(0, 0), cA, voffA); PG8_STAGE(PG8_SB(0, 1), cB + hstep, voffB); PG8_STAGE(PG8_SA(0, 1), cA + hstep, voffA);
        if (wr == 1) PG8_BAR;
        PG8_WAIT_V(4); PG8_BAR;
        PG8_STAGE(PG8_SB(1, 0), cB + kstep, voffB); PG8_STAGE(PG8_SA(1, 0), cA + kstep, voffA); PG8_STAGE(PG8_SB(1, 1), cB + hstep + kstep, voffB);
        PG8_WAIT_V(6); PG8_BAR;
    }
    for (;;) {
        const bool has_next = S.next(ui + 1, nxt);
        if constexpr (ScalesLds<Epi>::value) { if (wid == 0) {
            PG8_LAS unsigned* sdst = (PG8_LAS unsigned*)(lds + SCL_OFF + (ui & 1) * 2048);
            __builtin_amdgcn_global_load_lds((const unsigned*)E.row_scales(cur) + lane * 4, sdst, 16, 0, 0);
            __builtin_amdgcn_global_load_lds((const unsigned*)E.col_scales(cur) + lane * 4, sdst + 256, 16, 0, 0); } }
        const char* nA = has_next ? (const char*)g.A + (size_t)nxt.pm * tstep : cA; const char* nB = has_next ? (const char*)g.Bt + nxt.boff + (size_t)nxt.pn * tstep : cB;
        for (int t = 0; t < nt; t += 2) {
            const bool last = (t == nt - 2);
            const char* a1 = cA + (size_t)(t + 1) * kstep;
            const char* a2 = last ? nA : cA + (size_t)(t + 2) * kstep; const char* b2 = last ? nB : cB + (size_t)(t + 2) * kstep;
            const char* a3 = a2 + kstep; const char* b3 = b2 + kstep;
            if (last && has_next) S.a_ready(nxt);
            if constexpr (SP2) {
            PG8_LDB(B0, 0, 0); PG8_LDB(B1, 0, 1); PG8_SCHED; PG8_LDA(At, 0, 0); PG8_STAGE(PG8_SA(1, 1), a1 + hstep, voffA);
            PG8_WAIT_V(8); PG8_WAIT_L(0); PG8_BAR; PG8_MMA(0, 0, At, B0); PG8_MMA(0, 1, At, B1); PG8_BAR; PG8_SCHED;
            PG8_LDA(At, 0, 1); PG8_STAGE(PG8_SB(0, 0), b2, voffB); PG8_STAGE(PG8_SB(0, 1), b2 + hstep, voffB); PG8_STAGE(PG8_SA(0, 0), a2, voffA);
            PG8_WAIT_V(8); PG8_WAIT_L(0); PG8_BAR; PG8_MMA(1, 0, At, B0); PG8_MMA(1, 1, At, B1); PG8_BAR; PG8_SCHED;
            PG8_LDB(B0, 1, 0); PG8_LDB(B1, 1, 1); PG8_SCHED; PG8_LDA(At, 1, 0); PG8_STAGE(PG8_SA(0, 1), a2 + hstep, voffA);
            PG8_WAIT_V(8); PG8_WAIT_L(0); PG8_BAR; PG8_MMA(0, 0, At, B0); PG8_MMA(0, 1, At, B1); PG8_BAR; PG8_SCHED;
            PG8_LDA(At, 1, 1); PG8_STAGE(PG8_SB(1, 0), b3, voffB); PG8_STAGE(PG8_SB(1, 1), b3 + hstep, voffB); PG8_STAGE(PG8_SA(1, 0), a3, voffA);
            PG8_WAIT_V(8); PG8_WAIT_L(0); PG8_BAR; PG8_MMA(1, 0, At, B0); PG8_MMA(1, 1, At, B1); PG8_BAR; PG8_SCHED;
            } else {
            PG8_LDB(B0, 0, 0); PG8_SCHED; PG8_LDA(At, 0, 0); PG8_STAGE(PG8_SA(1, 1), a1 + hstep, voffA);
            PG8_WAIT_L(8); PG8_BAR; PG8_WAIT_L(0); PG8_MMA(0, 0, At, B0); PG8_BAR; PG8_SCHED;
            PG8_LDB(B1, 0, 1); PG8_STAGE(PG8_SB(0, 0), b2, voffB);
            PG8_BAR; PG8_WAIT_L(0); PG8_MMA(0, 1, At, B1); PG8_BAR;
            PG8_LDA(At, 0, 1); PG8_STAGE(PG8_SA(0, 0), a2, voffA);
            PG8_BAR; PG8_WAIT_L(0); PG8_MMA(1, 0, At, B0); PG8_BAR; PG8_SCHED;
            PG8_STAGE(PG8_SB(0, 1), b2 + hstep, voffB);
            PG8_WAIT_V(6); PG8_BAR; PG8_MMA(1, 1, At, B1); PG8_BAR;
            PG8_LDB(B0, 1, 0); PG8_SCHED; PG8_LDA(At, 1, 0); PG8_STAGE(PG8_SA(0, 1), a2 + hstep, voffA);
            PG8_WAIT_L(8); PG8_BAR; PG8_WAIT_L(0); PG8_MMA(0, 0, At, B0); PG8_BAR; PG8_SCHED;
            PG8_LDB(B1, 1, 1); PG8_STAGE(PG8_SB(1, 0), b3, voffB);
            PG8_BAR; PG8_WAIT_L(0); PG8_MMA(0, 1, At, B1); PG8_BAR;
            PG8_LDA(At, 1, 1); PG8_STAGE(PG8_SA(1, 0), a3, voffA);
            PG8_BAR; PG8_WAIT_L(0); PG8_MMA(1, 0, At, B0); PG8_BAR; PG8_SCHED;
            PG8_STAGE(PG8_SB(1, 1), b3 + hstep, voffB);
            PG8_WAIT_V(6); PG8_BAR; PG8_MMA(1, 1, At, B1); PG8_BAR;
            }
        }
        if constexpr (ALIGN_EPI) { if (wr == 0) PG8_BAR; }
        if constexpr (!Epi::AFTER_DRAIN) { if constexpr (ScalesLds<Epi>::value) E(acc, cur, wr, wc, fr, fq, (const PG8_LAS float*)(lds + SCL_OFF + (ui & 1) * 2048)); else E(acc, cur, wr, wc, fr, fq); S.done(cur); }
        if (!has_next) break;
#pragma unroll
        for (int a = 0; a < 2; ++a)
#pragma unroll
            for (int b = 0; b < 2; ++b)
#pragma unroll
                for (int m = 0; m < 4; ++m)
#pragma unroll
                    for (int n = 0; n < 2; ++n) acc[a][b][m][n] = acc_t{};
        cur = nxt; cA = nA; cB = nB; ++ui;
        if constexpr (ALIGN_EPI) { if (wr == 1) PG8_BAR; }
    }
    PG8_WAIT_V(0);
    if constexpr (!ALIGN_EPI) { if (wr == 0) PG8_BAR; }
    PG8_BAR;
    if constexpr (Epi::AFTER_DRAIN) { E.fused(acc, cur, wr, wc, fr, fq, lds, wid, lane); S.done(cur); }
#undef PG8_SA
#undef PG8_SB
#undef PG8_STAGE
#undef PG8_LDA
#undef PG8_LDB
#undef PG8_MMA
#undef PG8_WAIT_V
#undef PG8_WAIT_L
#undef PG8_BAR
#undef PG8_SCHED
}
}
namespace att {
typedef unsigned short bf16_t;
typedef short bf16x8 __attribute__((ext_vector_type(8)));
typedef short s16x4 __attribute__((ext_vector_type(4)));
typedef float f32x16 __attribute__((ext_vector_type(16)));
typedef float f32x4 __attribute__((ext_vector_type(4)));
typedef unsigned u32x4 __attribute__((ext_vector_type(4)));
constexpr int NW = 8, QBLK = 32, KVBLK = 64, PITCH = 2048;
constexpr int SHM_V = KVBLK * 128 * 2, SHM_K = KVBLK * 128 * 2;
constexpr int OFF_WS = 2 * SHM_V + 2 * SHM_K;
constexpr int OFF_FK = OFF_WS + NW * 64 * 4;
constexpr int OFF_TAB = OFF_FK + 2 * 64 * 4;
constexpr int LDS_BYTES = OFF_TAB + 2 * 260 * 4;
constexpr float THR = 12.f;
#define ATT_GAS __attribute__((address_space(1)))
template <class T> __device__ __forceinline__ T ldg(const void* base, unsigned boff) { return *(const ATT_GAS T*)((const ATT_GAS char*)base + boff); }
template <class T> __device__ __forceinline__ void stg(void* base, unsigned boff, T v) { *(ATT_GAS T*)((ATT_GAS char*)base + boff) = v; }
#define KSWZ(row, colB) ((row) * 256 + ((colB) ^ (((row) & 7) << 4)))
#define SBAR() __builtin_amdgcn_sched_barrier(0)
__device__ __forceinline__ int v_st(int k, int c) { const int kk = (k & ~0xC) | ((k & 4) << 1) | ((k & 8) >> 1); return ((kk >> 3) * 4 + (c >> 5)) * 512 + ((kk & 7) * 32 + (c & 31)) * 2; }
__device__ __forceinline__ int v_rd_base(int lane) { return ((lane & 3) << 3) | (((lane >> 2) & 3) << 6) | (((lane >> 4) & 1) << 5) | (((lane >> 5) & 1) << 8); }
constexpr int v_rd_off(int d0, int ks, int half) { return d0 * 512 + ks * 4096 + half * 2048; }
__device__ __forceinline__ int crow(int r, int hi) { return (r & 3) + 8 * (r >> 2) + 4 * hi; }
__device__ __forceinline__ unsigned cvtpk(float lo, float hi) { unsigned r; asm volatile("v_cvt_pk_bf16_f32 %0, %1, %2" : "=v"(r) : "v"(lo), "v"(hi)); return r; }
__device__ __forceinline__ void mask_tile(f32x16& p0, f32x16& p1, int dq) {
    const float NEG = -__builtin_inff();
#pragma unroll
    for (int r = 0; r < 16; ++r) { const int c = (r & 3) + 8 * (r >> 2);
        if (dq - c < 0) p0[r] = NEG;
        if (dq - c - 32 < 0) p1[r] = NEG; }
}
template <int MODE> __device__ __forceinline__ void partialSM(f32x16& p0, f32x16& p1, float& m_reg, float& mn, float& alpha) {
    constexpr float SCALE = MODE == 0 ? 0.08838834764831845f : 0.125f;
    float pm0 = fmaxf(p0[0], p0[1]), pm1 = fmaxf(p0[2], p0[3]), pm2 = fmaxf(p1[0], p1[1]), pm3 = fmaxf(p1[2], p1[3]);
#pragma unroll
    for (int r = 4; r < 16; r += 4) { pm0 = fmaxf(fmaxf(pm0, p0[r]), p0[r + 1]); pm1 = fmaxf(fmaxf(pm1, p0[r + 2]), p0[r + 3]); pm2 = fmaxf(fmaxf(pm2, p1[r]), p1[r + 1]); pm3 = fmaxf(fmaxf(pm3, p1[r + 2]), p1[r + 3]); }
    float pmax = fmaxf(fmaxf(pm0, pm1), fmaxf(pm2, pm3));
    { auto rr = __builtin_amdgcn_permlane32_swap(__float_as_uint(pmax), __float_as_uint(pmax), false, false);
      pmax = fmaxf(__uint_as_float(rr[0]), __uint_as_float(rr[1])); }
    constexpr float C2 = 1.4426950408889634f * SCALE;
    if (__builtin_expect(__all((pmax - m_reg) * SCALE <= THR), 1)) { mn = m_reg; alpha = 1.f; }
    else { mn = fmaxf(m_reg, pmax); alpha = __builtin_amdgcn_exp2f((m_reg - mn) * C2); m_reg = mn; }
    const float mnL = -mn * C2;
#pragma unroll
    for (int r = 0; r < 16; ++r) p0[r] = fmaf(p0[r], C2, mnL);
#pragma unroll
    for (int r = 0; r < 16; ++r) p1[r] = fmaf(p1[r], C2, mnL);
#pragma unroll
    for (int r = 0; r < 16; ++r) p0[r] = __builtin_amdgcn_exp2f(p0[r]);
}
__device__ __forceinline__ void finishSM(f32x16& p0, f32x16& p1, float alpha, float& l_reg, bf16x8& pa0, bf16x8& pa1, bf16x8& pa2, bf16x8& pa3) {
#pragma unroll
    for (int r = 0; r < 16; ++r) p1[r] = __builtin_amdgcn_exp2f(p1[r]);
    float ps0 = p0[0], ps1 = p0[1], ps2 = p1[0], ps3 = p1[1];
#pragma unroll
    for (int r = 2; r < 16; r += 2) { ps0 += p0[r]; ps1 += p0[r + 1]; ps2 += p1[r]; ps3 += p1[r + 1]; }
    float ps = (ps0 + ps1) + (ps2 + ps3);
    { auto rr = __builtin_amdgcn_permlane32_swap(__float_as_uint(ps), __float_as_uint(ps), false, false);
      ps = __uint_as_float(rr[0]) + __uint_as_float(rr[1]); }
    l_reg = l_reg * alpha + ps;
#define PK4(P, B_, OUT) do { unsigned a0 = cvtpk(P[B_+0], P[B_+1]), a1 = cvtpk(P[B_+2], P[B_+3]);                          \
        unsigned b0 = cvtpk(P[B_+4], P[B_+5]), b1 = cvtpk(P[B_+6], P[B_+7]);                                             \
        auto r0 = __builtin_amdgcn_permlane32_swap(a0, b0, false, false); auto r1 = __builtin_amdgcn_permlane32_swap(a1, b1, false, false); \
        u32x4 w = {r0[0], r1[0], r0[1], r1[1]}; OUT = *reinterpret_cast<bf16x8*>(&w); } while (0)
    PK4(p0, 0, pa0); PK4(p0, 8, pa1); PK4(p1, 0, pa2); PK4(p1, 8, pa3);
#undef PK4
}
struct BiasCtx { float fq; int qi128; int cw; int hd; };
template <int KB, int MODE>
__device__ __forceinline__ void qkt(f32x16& p0, f32x16& p1, const char* lds, int r32, int hi, const bf16x8* qr, bool act, const BiasCtx& bc, int jt) {
    if (MODE == 1 && !act) { const float NEG = -__builtin_inff();
#pragma unroll
        for (int r = 0; r < 16; ++r) { p0[r] = NEG; p1[r] = NEG; } return; }
    if constexpr (MODE == 0) {
        const float* fk = (const float*)(lds + OFF_FK + KB * 256);
#pragma unroll
        for (int g = 0; g < 4; ++g) { const f32x4 f = *(const f32x4*)(fk + 8 * g + 4 * hi);
            p0[4 * g + 0] = bc.fq - f[0]; p0[4 * g + 1] = bc.fq - f[1]; p0[4 * g + 2] = bc.fq - f[2]; p0[4 * g + 3] = bc.fq - f[3]; }
#pragma unroll
        for (int g = 0; g < 4; ++g) { const f32x4 f = *(const f32x4*)(fk + 32 + 8 * g + 4 * hi);
            p1[4 * g + 0] = bc.fq - f[0]; p1[4 * g + 1] = bc.fq - f[1]; p1[4 * g + 2] = bc.fq - f[2]; p1[4 * g + 3] = bc.fq - f[3]; }
    } else {
        const float* tab = (const float*)(lds + OFF_TAB) + bc.hd * 260;
        const int delta = bc.cw - jt;
        if (delta >= 3) { const float c = tab[256];
#pragma unroll
            for (int r = 0; r < 16; ++r) { p0[r] = c; p1[r] = c; } }
        else { const int base = 64 * delta + bc.qi128 - 4 * hi;
#pragma unroll
            for (int r = 0; r < 16; ++r) { const int kj = (r & 3) + 8 * (r >> 2); int i0 = base - kj, i1 = base - kj - 32; i0 = i0 > 256 ? 256 : i0; i1 = i1 > 256 ? 256 : i1;
                p0[r] = tab[i0]; p1[r] = tab[i1]; } }
    }
    const char* K_lds = lds + 2 * SHM_V;
    const char* kb[4];
#pragma unroll
    for (int dd = 0; dd < 4; ++dd) kb[dd] = K_lds + KB * SHM_K + KSWZ(r32, (dd * 16 + hi * 8) * 2);
    if constexpr (MODE == 0) {
#pragma unroll
        for (int d0 = 0; d0 < 8; ++d0) { const char* a = kb[d0 & 3] + (d0 >> 2) * 128;
            const bf16x8 b0 = *reinterpret_cast<const bf16x8*>(a);
            const bf16x8 b1 = *reinterpret_cast<const bf16x8*>(a + 32 * 256);
            p0 = __builtin_amdgcn_mfma_f32_32x32x16_bf16(b0, qr[d0], p0, 0, 0, 0);
            p1 = __builtin_amdgcn_mfma_f32_32x32x16_bf16(b1, qr[d0], p1, 0, 0, 0); }
    } else {
#pragma unroll
        for (int dd = 0; dd < 4; ++dd) { const char* a = kb[dd] + bc.hd * 128;
            const bf16x8 b0 = *reinterpret_cast<const bf16x8*>(a);
            const bf16x8 b1 = *reinterpret_cast<const bf16x8*>(a + 32 * 256);
            p0 = __builtin_amdgcn_mfma_f32_32x32x16_bf16(b0, qr[dd], p0, 0, 0, 0);
            p1 = __builtin_amdgcn_mfma_f32_32x32x16_bf16(b1, qr[dd], p1, 0, 0, 0); }
    }
}
template <int VB, int ND>
__device__ __forceinline__ void pv_tile(f32x16* o, int vb0, bf16x8 pa0, bf16x8 pa1, bf16x8 pa2, bf16x8 pa3, bool act) {
    if (!act) return;
#define TRRD(dst, off) asm volatile("ds_read_b64_tr_b16 %0, %1 offset:%2" : "=&v"(dst) : "v"(vb0), "i"(off) : "memory")
#define PV_D0(d0) do { s16x4 l0, l1, l2, l3, h0, h1, h2, h3; constexpr int b_ = VB * SHM_V + v_rd_off(d0, 0, 0);   \
        TRRD(l0, b_); TRRD(h0, b_ + 2048); TRRD(l1, b_ + 4096); TRRD(h1, b_ + 6144); TRRD(l2, b_ + 8192); TRRD(h2, b_ + 10240); TRRD(l3, b_ + 12288); TRRD(h3, b_ + 14336); \
        asm volatile("s_waitcnt lgkmcnt(0)" ::: "memory"); SBAR();   \
        o[d0] = __builtin_amdgcn_mfma_f32_32x32x16_bf16(pa0, (bf16x8){l0[0], l0[1], l0[2], l0[3], h0[0], h0[1], h0[2], h0[3]}, o[d0], 0, 0, 0);   \
        o[d0] = __builtin_amdgcn_mfma_f32_32x32x16_bf16(pa1, (bf16x8){l1[0], l1[1], l1[2], l1[3], h1[0], h1[1], h1[2], h1[3]}, o[d0], 0, 0, 0);   \
        o[d0] = __builtin_amdgcn_mfma_f32_32x32x16_bf16(pa2, (bf16x8){l2[0], l2[1], l2[2], l2[3], h2[0], h2[1], h2[2], h2[3]}, o[d0], 0, 0, 0);   \
        o[d0] = __builtin_amdgcn_mfma_f32_32x32x16_bf16(pa3, (bf16x8){l3[0], l3[1], l3[2], l3[3], h3[0], h3[1], h3[2], h3[3]}, o[d0], 0, 0, 0); } while (0)
    PV_D0(0); PV_D0(1);
    if constexpr (ND == 4) { PV_D0(2); PV_D0(3); }
#undef PV_D0
#undef TRRD
}
struct Blk { const bf16_t* Q; const bf16_t* K; const bf16_t* V; bf16_t* O; const float* F; const float* tab; int P0; int j_lo; };
template <int MODE>
__device__ __forceinline__ void attn_block(const Blk& cur, char* lds, const int tid) {
    constexpr int ND = MODE == 0 ? 4 : 2, NQ = MODE == 0 ? 8 : 4;
    constexpr float INVS = 11.313708498984761f;
    const int wid = __builtin_amdgcn_readfirstlane(tid >> 6), lane = tid & 63, r32 = lane & 31, hi = lane >> 5;
    const int hd = MODE == 1 ? (wid >> 2) : 0, rb = MODE == 1 ? (wid & 3) : wid;
    const int C0 = cur.P0 / KVBLK;
    int j_lo, j_hi;
    if (MODE == 0) { j_lo = cur.j_lo; j_hi = C0 + 4; } else { j_lo = C0 - 8 < 0 ? 0 : C0 - 8; j_hi = C0 + 2; }
    const int NT = j_hi - j_lo;
    const int qlo = cur.P0 + rb * QBLK, qm = qlo + r32 - 4 * hi;
    BiasCtx bc; bc.fq = 0.f; bc.hd = hd; bc.cw = C0 + (rb >> 1); bc.qi128 = (rb & 1) * 32 + r32 + 128;
    char* V_lds = lds; char* K_lds = lds + 2 * SHM_V;
    float* ws = (float*)(lds + OFF_WS) + wid * 64; float* li_l = ws; float* al_l = ws + 32;
    float m_reg = -1e30f, l_reg = 0; f32x16 o[ND];
#pragma unroll
    for (int d = 0; d < ND; ++d) o[d] = f32x16{};
    const int sr = tid >> 4, sc = (tid & 15) * 8, vst0 = v_st(sr, sc), kws = KSWZ(sr, sc * 2);
    const int vb0 = (int)(uintptr_t)V_lds + v_rd_base(lane) + hd * 1024;
    const bf16_t* Kh = cur.K; const bf16_t* Vh = cur.V;
    bf16x8 st_v0, st_v1, st_k0, st_k1; float st_f = 0.f, fref = 0.f;
    const unsigned goff0 = (unsigned)(sr * PITCH + sc) * 2u, goff1 = goff0 + 32u * PITCH * 2u;
#define VMW() asm volatile("s_waitcnt vmcnt(0)" ::: "memory")
#define SLOAD_H(k0) do { const bf16_t* vt_ = Vh + (size_t)(k0) * PITCH; const bf16_t* kt_ = Kh + (size_t)(k0) * PITCH;                \
                         st_v0 = ldg<bf16x8>(vt_, goff0); st_v1 = ldg<bf16x8>(vt_, goff1); st_k0 = ldg<bf16x8>(kt_, goff0); st_k1 = ldg<bf16x8>(kt_, goff1); \
                         if (MODE == 0 && wid == 0) st_f = ldg<float>(cur.F + (k0), (unsigned)lane * 4u); } while (0)
#define SWRITE_HK(bf) do { *(bf16x8*)(K_lds + (bf) * SHM_K + kws) = st_k0; *(bf16x8*)(K_lds + (bf) * SHM_K + kws + 32 * 256) = st_k1; \
                           if (MODE == 0 && wid == 0) *(float*)(lds + OFF_FK + (bf) * 256 + lane * 4) = (st_f - fref) * INVS; } while (0)
#define SWRITE_HV(bf) do { *(bf16x8*)(V_lds + (bf) * SHM_V + vst0) = st_v0; *(bf16x8*)(V_lds + (bf) * SHM_V + vst0 + 8192) = st_v1; } while (0)
#define SWRITE_H(bf) do { SWRITE_HV(bf); SWRITE_HK(bf); } while (0)
#define RESC(a) do { if (__any((a) < 1.f)) { if (hi == 0) al_l[r32] = (a); asm volatile("s_waitcnt lgkmcnt(0)" ::: "memory");              \
                     _Pragma("unroll") for (int d_ = 0; d_ < ND; ++d_) _Pragma("unroll") for (int r = 0; r < 16; ++r) o[d_][r] *= al_l[crow(r, hi)]; } } while (0)
#define KBASE(t) ((j_lo + (t)) * KVBLK)
#define ACT(t) (MODE == 0 ? true : ((j_lo + (t)) >= bc.cw - 8 && (j_lo + (t)) <= bc.cw))
#define MASKT(P0_, P1_, t) do { if (MODE == 0) { const int kb_ = KBASE(t); if (kb_ + KVBLK - 1 > qlo) mask_tile(P0_, P1_, qm - kb_); } } while (0)
    bf16x8 qr[NQ];
    { const unsigned qoff = (unsigned)((rb * QBLK + r32) * PITCH + hd * 64 + hi * 8) * 2u;
#pragma unroll
      for (int d0 = 0; d0 < NQ; ++d0) qr[d0] = ldg<bf16x8>(cur.Q, qoff + d0 * 32u); }
    if constexpr (MODE == 0) { fref = __uint_as_float(__builtin_amdgcn_readfirstlane(__float_as_uint(ldg<float>(cur.F + cur.P0, 0u)))); bc.fq = (ldg<float>(cur.F + qlo, (unsigned)r32 * 4u) - fref) * INVS; }
    else { float* tab = (float*)(lds + OFF_TAB); for (int i = tid; i < 2 * 257; i += 64 * NW) { const int h2 = i >= 257 ? 1 : 0; tab[h2 * 260 + (i - h2 * 257)] = cur.tab[i] * 8.0f; } }
    SLOAD_H(KBASE(0)); VMW(); SWRITE_HK(0);
    __syncthreads();
    f32x16 pA0, pA1, pB0, pB1; float mnA, mnB, alA, alB; bf16x8 pa0, pa1, pa2, pa3;
    SWRITE_HV(0); SBAR();
    if (NT > 1) SLOAD_H(KBASE(1));
    SBAR(); qkt<0, MODE>(pA0, pA1, lds, r32, hi, qr, ACT(0), bc, j_lo);
    MASKT(pA0, pA1, 0); partialSM<MODE>(pA0, pA1, m_reg, mnA, alA);
    if (NT > 1) { VMW(); SWRITE_H(1); }
    __syncthreads();
#define HALF_STEP(PX0, PX1, mnX, alX, PY0, PY1, alY, t, KB, VB, SB) do {                                                      \
        SBAR(); qkt<KB, MODE>(PX0, PX1, lds, r32, hi, qr, ACT(t), bc, j_lo + (t));                                            \
        finishSM(PY0, PY1, alY, l_reg, pa0, pa1, pa2, pa3); SBAR();                                                           \
        if ((t) + 1 < NT) { SLOAD_H(KBASE((t) + 1)); SBAR(); }                                                               \
        pv_tile<VB, ND>(o, vb0, pa0, pa1, pa2, pa3, ACT((t) - 1)); MASKT(PX0, PX1, (t)); partialSM<MODE>(PX0, PX1, m_reg, mnX, alX);  \
        __syncthreads();                                                                                                      \
        if ((t) + 1 < NT) { VMW(); SWRITE_H(SB); }                                                                            \
        RESC(alX); __syncthreads(); } while (0)
    for (int t = 1; t + 1 < NT; t += 2) {
        HALF_STEP(pB0, pB1, mnB, alB, pA0, pA1, alA, t, 1, 0, 0);
        HALF_STEP(pA0, pA1, mnA, alA, pB0, pB1, alB, t + 1, 0, 1, 1);
    }
    const bool even = (NT & 1) == 0;
    if (even) { SBAR(); qkt<1, MODE>(pB0, pB1, lds, r32, hi, qr, ACT(NT - 1), bc, j_lo + NT - 1); SBAR(); }
    finishSM(pA0, pA1, alA, l_reg, pa0, pa1, pa2, pa3); SBAR();
    pv_tile<0, ND>(o, vb0, pa0, pa1, pa2, pa3, ACT(even ? NT - 2 : NT - 1));
    if (even) { MASKT(pB0, pB1, NT - 1); partialSM<MODE>(pB0, pB1, m_reg, mnB, alB); __syncthreads(); RESC(alB);
        finishSM(pB0, pB1, alB, l_reg, pa0, pa1, pa2, pa3); SBAR(); pv_tile<1, ND>(o, vb0, pa0, pa1, pa2, pa3, ACT(NT - 1)); }
    if (hi == 0) li_l[r32] = l_reg; asm volatile("s_waitcnt lgkmcnt(0)" ::: "memory");
    float rli[16];
#pragma unroll
    for (int r = 0; r < 16; ++r) rli[r] = __builtin_amdgcn_rcpf(li_l[crow(r, hi)]);
    bf16_t* Ow = cur.O + (size_t)(rb * QBLK) * PITCH + hd * 64;
    int le = lane; asm volatile("" : "+v"(le));
    const unsigned ooff = (unsigned)(4 * (le >> 5) * PITCH + (le & 31)) * 2u;
#pragma unroll
    for (int r = 0; r < 16; ++r) { const unsigned orow = (r & 3) + 8 * (r >> 2);
#pragma unroll
        for (int d0 = 0; d0 < ND; ++d0) { const float v = o[d0][r] * rli[r]; const float vn = __shfl_xor(v, 1);
            if ((r32 & 1) == 0) stg<unsigned>(Ow, ooff + (orow * PITCH + d0 * 32) * 2u, cvtpk(v, vn)); } }
    __syncthreads();
#undef VMW
#undef SLOAD_H
#undef SWRITE_HK
#undef SWRITE_HV
#undef SWRITE_H
#undef RESC
#undef KBASE
#undef ACT
#undef MASKT
#undef HALF_STEP
}
#undef KSWZ
#undef SBAR
}
constexpr int NWAVES = 8;
constexpr int N_LAUNCHES = MK_N_LAUNCHES;
constexpr int N_PHASES = 22;
constexpr int NB = 2, SEQ = 16384, DM = 2048, N_TOK = NB * SEQ, NE = 16;
constexpr int CH_TOK = 128, N_CH = N_TOK / CH_TOK;
constexpr int MAX_BLK = 272, MAX_SLOT = MAX_BLK * 256;
constexpr float ALPHA = 1.4142135623730951f, LN_EPS = 1e-5f;

constexpr size_t MiB = 1u << 20;
constexpr size_t WS_CTL = 0, CTL_ZERO_BYTES = 1 * MiB;
constexpr size_t WS_SMALL = 2 * MiB;
constexpr size_t SM_TOKE = 0, SM_TOKG = 256 * 1024, SM_SLOTOF = 512 * 1024, SM_SLOTG = 768 * 1024;
constexpr size_t SM_WGCNT = 1088 * 1024, SM_BLK = 1104 * 1024, SM_CHT = 1108 * 1024;
constexpr size_t SM_DMIN = 1128 * 1024;
constexpr size_t SM_FLOC = 2 * MiB, SM_FF = 4 * MiB;
constexpr size_t SM_ASCX = 6 * MiB, SM_ASC1 = SM_ASCX + 128 * 1024, SM_ASC2 = SM_ASC1 + 128 * 1024, SM_SLOTSC = SM_ASC2 + 128 * 1024;
constexpr size_t SM_WSCQKV = 7 * MiB, SM_WSCKVQ = SM_WSCQKV + 32 * 1024, SM_WSCGU = SM_WSCKVQ + 32 * 1024, SM_WSCD = SM_WSCGU + 576 * 1024;
constexpr size_t SM_WSCAO = SM_WSCD + 256 * 1024, SM_WSCBO = SM_WSCAO + 8 * 1024;
constexpr size_t SM_HSC = 8 * MiB, SM_ASCAO = SM_HSC + 512 * 1024;
constexpr size_t WS_WQKV8 = 12 * MiB, WS_WKVQ8 = 24 * MiB;
constexpr size_t WS_WAO = 36 * MiB, WS_WBO = 44 * MiB;
constexpr size_t WS_WGU8 = 52 * MiB;
constexpr size_t WS_WD8 = 308 * MiB;
constexpr size_t WS_HMAX = 436 * MiB;
constexpr size_t WS_R1 = 454 * MiB;
constexpr size_t WS_R2 = 726 * MiB;
constexpr size_t WS_R3 = 854 * MiB;
constexpr size_t WS_XA8 = 982 * MiB, WS_XQ8 = 1046 * MiB;
constexpr size_t WS_R4 = 1110 * MiB;
constexpr size_t WS_R5 = 1494 * MiB;
constexpr size_t WS_END = 1630 * MiB;
constexpr int CW_BAR = 4096;
constexpr int CW_QHEAD2 = 8448;
constexpr int CW_NORM = 8192, CW_QHEAD = 8320;

constexpr int RING_BYTES = 131072;
constexpr int MISC_OFF = RING_BYTES;
constexpr int TBL_OFF = RING_BYTES + 256;
constexpr int LF_OFF = RING_BYTES + 2048;
constexpr int GB_OFF = LF_OFF + 8192;
constexpr int LDS_BYTES = 163840;
static_assert(GB_OFF + 16384 <= LDS_BYTES && att::LDS_BYTES <= RING_BYTES, "LDS map");

#define GAS __attribute__((address_space(1)))
#define LAS __attribute__((address_space(3)))
typedef unsigned short bf16;
typedef unsigned v4u __attribute__((ext_vector_type(4)));
typedef float f32x4 __attribute__((ext_vector_type(4)));
typedef short bf16x8 __attribute__((ext_vector_type(8)));
typedef GAS unsigned gu32;
typedef GAS unsigned long long gu64;
#define RLX_AGENT __ATOMIC_RELAXED, __HIP_MEMORY_SCOPE_AGENT
#define LDS_WAIT() asm volatile("s_waitcnt lgkmcnt(0)" ::: "memory")
#define VM_WAIT() asm volatile("s_waitcnt vmcnt(0)" ::: "memory")
__device__ __forceinline__ unsigned long long rt() { return __builtin_amdgcn_s_memrealtime(); }
__device__ __forceinline__ unsigned f2bf(float f) { unsigned u = __builtin_bit_cast(unsigned, f); return (u + 0x7fffu + ((u >> 16) & 1u)) >> 16; }
__device__ __forceinline__ unsigned pk2(float lo, float hi) { return f2bf(lo) | (f2bf(hi) << 16); }

#define XB_TMO      128
#define XB_XCNT(j)  (256  + 64 * (j))
#define XB_XSUB(j)  (1280 + 64 * (j))
#define XB_XGEN(j)  (2304 + 64 * (j))
#define XB_TOP      3328
#define XB_TOPGEN   3392
#define XCD_BAR_WORDS 3456
#define XB_SPIN_CAP (1u << 18)

__device__ __forceinline__ unsigned xb_ld(unsigned* p)              { return __hip_atomic_load(p, __ATOMIC_RELAXED, __HIP_MEMORY_SCOPE_AGENT); }
__device__ __forceinline__ unsigned xb_add(unsigned* p, unsigned v) { return __hip_atomic_fetch_add(p, v, __ATOMIC_RELAXED, __HIP_MEMORY_SCOPE_AGENT); }
__device__ __forceinline__ unsigned xb_xcc_id() { return (unsigned)__builtin_amdgcn_s_getreg((3 << 11) | 20) & 0xFu; }
#define XB_SPIN(cond, bar) do { unsigned _sp = 0; while (cond) { __builtin_amdgcn_s_sleep(1); \
    if ((++_sp & 255u) == 0u) { if (xb_ld(&(bar)[XB_TMO])) break; if (_sp > XB_SPIN_CAP) { atomicAdd(&(bar)[XB_TMO], 1u); break; } } } } while (0)

struct XcdBarrier {
    unsigned* bar; unsigned x;
    volatile LAS unsigned* st;
};

__device__ __forceinline__ XcdBarrier xcd_barrier_post(unsigned* bar, volatile LAS unsigned* st, const bool tid0  ) {
    XcdBarrier b; b.bar = bar; b.x = xb_xcc_id(); b.st = st;
    if (tid0) (void)xb_add(&bar[XB_XCNT(b.x)], 1u);
    return b;
}
__device__ __forceinline__ void xcd_barrier_complete(unsigned* bar, unsigned x, unsigned& nloc, unsigned& nx) {
    const unsigned G = gridDim.x * gridDim.y * gridDim.z;
    unsigned sum, cnt, mine, sp = 0u;
    for (;;) {
        sum = 0u; cnt = 0u; mine = 0u;
#pragma unroll
        for (unsigned j = 0; j < 16; ++j) { const unsigned c = xb_ld(&bar[XB_XCNT(j)]); sum += c; cnt += (c > 0u) ? 1u : 0u; mine = (j == x) ? c : mine; }
        if (sum == G) break;
        __builtin_amdgcn_s_sleep(1);
        if ((++sp & 255u) == 0u) { if (xb_ld(&bar[XB_TMO])) break; if (sp > XB_SPIN_CAP) { atomicAdd(&bar[XB_TMO], 1u); break; } }
    }
    nloc = mine > 0u ? mine : 1u; nx = cnt > 0u ? cnt : 1u;
}

__device__ __forceinline__ void xcd_barrier(const XcdBarrier& b, const bool tid0  ) {
    asm volatile("s_waitcnt vmcnt(0)" ::: "memory");
    __syncthreads();
    if (tid0) {
        unsigned* bar = b.bar;
        __builtin_amdgcn_s_waitcnt(0);
        unsigned nloc = b.st[0], nx = b.st[1];
        if (nloc == 0u) { xcd_barrier_complete(bar, b.x, nloc, nx); b.st[0] = nloc; b.st[1] = nx; }
        const unsigned old = xb_add(&bar[XB_XSUB(b.x)], 1u);
        const unsigned gen = old / nloc;
        if (old + 1u == (gen + 1u) * nloc) {
            __builtin_amdgcn_fence(__ATOMIC_RELEASE, "agent");
            asm volatile("s_waitcnt vmcnt(0)" ::: "memory");
            const unsigned og = xb_add(&bar[XB_TOP], 1u);
            const unsigned tg = og / nx;
            if (og + 1u == (tg + 1u) * nx) xb_add(&bar[XB_TOPGEN], 1u);
            else XB_SPIN(xb_ld(&bar[XB_TOPGEN]) == tg, bar);
            __builtin_amdgcn_fence(__ATOMIC_ACQUIRE, "agent");
            xb_add(&bar[XB_XGEN(b.x)], 1u);
            asm volatile("s_waitcnt vmcnt(0)" ::: "memory");
        } else {
            XB_SPIN(xb_ld(&bar[XB_XGEN(b.x)]) == gen, bar);
            __builtin_amdgcn_fence(__ATOMIC_ACQUIRE, "agent");
            asm volatile("s_waitcnt vmcnt(0)" ::: "memory");
        }
    }
    __syncthreads();
}

struct Frame {
    LAS unsigned char* lds;
    volatile LAS unsigned* MISC;
    int tid, lane, wave;
    int vcu, G;
};
struct Ptrs {
    const float *x, *w_qkv, *rel_bias, *w_ao, *w_kv, *fg_w, *fg_b, *w_bq, *w_bo, *router_w, *router_b, *w_gate, *w_up, *w_down, *ln_gain, *ln_bias;
    float* out;
    unsigned char *Wqkv8, *Wkvq8, *Wao8, *Wbo8, *Wgu8, *Wd8, *XA8, *XQ8, *XS8, *HID8, *AO8;
    float *wsc_qkv, *wsc_kvq, *wsc_ao, *wsc_bo, *wsc_gu, *wsc_d, *asc_x, *asc_1, *asc_2, *asc_ao, *slot_sc, *hsc, *hmax;
    bf16 *SH, *XA, *XB, *QKV, *XS, *AO;
    int *tok_e, *slot_of, *wgcnt, *blk; float *tok_g, *slot_g, *cht, *floc, *ff, *dmin;
};

typedef unsigned u32x2 __attribute__((ext_vector_type(2)));
#define MEMFENCE() asm volatile("" ::: "memory")
template <class T> __device__ __forceinline__ T ldg(const void* base, unsigned boff) { return *(const GAS T*)((const GAS char*)base + boff); }
template <class T> __device__ __forceinline__ void stg(void* base, unsigned boff, T v) { *(GAS T*)((GAS char*)base + boff) = v; }
template <int CTRL, int RMASK> __device__ __forceinline__ float dpp_mov0(float v) { return __int_as_float(__builtin_amdgcn_update_dpp(0, __float_as_int(v), CTRL, RMASK, 0xf, false)); }
__device__ __forceinline__ float wave_sum(float v) {
    v += dpp_mov0<0xB1, 0xf>(v); v += dpp_mov0<0x4E, 0xf>(v); v += dpp_mov0<0x141, 0xf>(v); v += dpp_mov0<0x140, 0xf>(v);
    v += dpp_mov0<0x142, 0xa>(v); v += dpp_mov0<0x143, 0xc>(v);
    return __uint_as_float(__builtin_amdgcn_readlane(__float_as_uint(v), 63));
}
__device__ __forceinline__ float wave_max_nonneg(float v) {
    v = fmaxf(v, dpp_mov0<0xB1, 0xf>(v)); v = fmaxf(v, dpp_mov0<0x4E, 0xf>(v)); v = fmaxf(v, dpp_mov0<0x141, 0xf>(v)); v = fmaxf(v, dpp_mov0<0x140, 0xf>(v));
    v = fmaxf(v, dpp_mov0<0x142, 0xa>(v)); v = fmaxf(v, dpp_mov0<0x143, 0xc>(v));
    return __uint_as_float(__builtin_amdgcn_readlane(__float_as_uint(v), 63));
}
constexpr int CV8_EXPERT_STRIPS = 16 * 3 * 64;
__device__ __forceinline__ void cv8_strip(Frame& F, const float* src, int ldw, int n0, unsigned char* dst8, int drow0, float* wsc) {
    LAS float* scr = (LAS float*)(F.lds + F.wave * 16384);
    LAS float* cmx = (LAS float*)(F.lds + F.wave * 16384 + 12288);
    const int lane = F.lane, kw = F.wave * 256;
    float r[4][32];
#pragma unroll
    for (int q = 0; q < 4; ++q) { const float* p = src + (size_t)(kw + 64 * q) * ldw + n0;
        const unsigned lo = (unsigned)((lane >> 5) * ldw + (lane & 31)) * 4u, st = (unsigned)ldw * 8u;
#pragma unroll
        for (int i = 0; i < 32; ++i) r[q][i] = __builtin_nontemporal_load((const GAS float*)((const GAS char*)p + (lo + i * st))); }
    float m = 0.f;
#pragma unroll
    for (int q = 0; q < 4; ++q)
#pragma unroll
        for (int i = 0; i < 32; ++i) m = fmaxf(m, fabsf(r[q][i]));
    m = fmaxf(m, __shfl_xor(m, 32));
    if (lane < 32) cmx[lane] = m;
    __syncthreads();
    float cm = 0.f;
#pragma unroll
    for (int w = 0; w < NWAVES; ++w) cm = fmaxf(cm, ((LAS float*)(F.lds + w * 16384 + 12288))[lane & 31]);
    const float inv = cm > 0.f ? 127.f / cm : 0.f;
    if (F.wave == 0 && lane < 32) wsc[drow0 + lane] = cm * (1.f / 127.f);
    const int c4 = lane & 3;
#pragma unroll
    for (int q = 0; q < 4; ++q) {
#pragma unroll
        for (int i = 0; i < 32; ++i) scr[(2 * i + (lane >> 5)) * 33 + (lane & 31)] = r[q][i] * inv;
        LDS_WAIT(); asm volatile("" ::: "memory");
#pragma unroll
        for (int h = 0; h < 2; ++h) { const int n = (lane >> 2) + 16 * h; const LAS float* s2 = scr + (16 * c4) * 33 + n; unsigned w[4];
#pragma unroll
            for (int d = 0; d < 4; ++d) { const int q0 = __float2int_rn(s2[(4 * d) * 33]), q1 = __float2int_rn(s2[(4 * d + 1) * 33]), q2 = __float2int_rn(s2[(4 * d + 2) * 33]), q3 = __float2int_rn(s2[(4 * d + 3) * 33]);
                w[d] = (unsigned)(q0 & 255) | ((unsigned)(q1 & 255) << 8) | ((unsigned)(q2 & 255) << 16) | ((unsigned)q3 << 24); }
            const v4u o = {w[0], w[1], w[2], w[3]};
            *(GAS v4u*)(dst8 + (size_t)(drow0 + n) * 2048 + kw + 64 * q + 16 * c4) = o; }
        LDS_WAIT(); asm volatile("" ::: "memory");
    }
    __syncthreads();
}
__device__ __forceinline__ void cv8_dense(Frame& F, const Ptrs& P, int sid) {
    const int b8 = sid >> 6, n0 = (sid & 63) * 32;
    const float* src; int ldw = 2048; unsigned char* dst; float* wsc;
    if (b8 < 3) { src = P.w_qkv + b8 * 2048; ldw = 6144; dst = P.Wqkv8 + (size_t)b8 * 2048 * 2048; wsc = P.wsc_qkv + b8 * 2048; }
    else if (b8 < 5) { src = P.w_kv + (b8 - 3) * 2048; ldw = 4096; dst = P.Wkvq8 + (size_t)(b8 - 3) * 2048 * 2048; wsc = P.wsc_kvq + (b8 - 3) * 2048; }
    else if (b8 == 5) { src = P.w_bq; dst = P.Wkvq8 + (size_t)2 * 2048 * 2048; wsc = P.wsc_kvq + 4096; }
    else if (b8 == 6) { src = P.w_ao; dst = P.Wao8; wsc = P.wsc_ao; }
    else { src = P.w_bo; dst = P.Wbo8; wsc = P.wsc_bo; }
    cv8_strip(F, src, ldw, n0, dst, n0, wsc);
}
__device__ __forceinline__ void cv8_expert(Frame& F, const Ptrs& P, int layer, int sid) {
    const int e = sid / 192, rr = sid - e * 192, kind = rr >> 6, n0 = (rr & 63) * 32, le = layer * 16 + e;
    const float* src; unsigned char* dst; float* wsc; int drow0;
    if (kind == 2) { src = P.w_down + (size_t)le * 2048 * 2048; dst = P.Wd8 + (size_t)le * 2048 * 2048; wsc = P.wsc_d + (size_t)le * 2048; drow0 = n0; }
    else { src = (kind ? P.w_up : P.w_gate) + (size_t)le * 2048 * 2048; dst = P.Wgu8 + (size_t)le * 4096 * 2048; wsc = P.wsc_gu + (size_t)le * 4096; drow0 = 256 * (n0 >> 7) + (n0 & 127) + 128 * kind; }
    cv8_strip(F, src, 2048, n0, dst, drow0, wsc);
}
__device__ __forceinline__ void cv_side(Frame& F, const Ptrs& P, int layer) {
    if (F.G < 8) { for (int sid = F.vcu; sid < CV8_EXPERT_STRIPS; sid += F.G) cv8_expert(F, P, layer, sid); return; }
    if ((F.vcu & 1) != 1) return;
    const int ncv = F.G >> 1, rank = F.vcu >> 1;
#pragma unroll 1
    for (int sid = rank; sid < CV8_EXPERT_STRIPS; sid += ncv) cv8_expert(F, P, layer, sid);
}
__device__ __forceinline__ float quant_row_store(unsigned char* dst, const f32x4 (&v)[8], int lane) {
    float m = 0.f;
#pragma unroll
    for (int j = 0; j < 8; ++j) m = fmaxf(fmaxf(m, fmaxf(fabsf(v[j].x), fabsf(v[j].y))), fmaxf(fabsf(v[j].z), fabsf(v[j].w)));
    m = wave_max_nonneg(m);
    const float inv = m > 0.f ? 127.f / m : 0.f;
#pragma unroll
    for (int j = 0; j < 8; ++j) { const int q0 = __float2int_rn(v[j].x * inv), q1 = __float2int_rn(v[j].y * inv), q2 = __float2int_rn(v[j].z * inv), q3 = __float2int_rn(v[j].w * inv);
        stg<unsigned>(dst, (unsigned)(64 * j + lane) * 4u, (unsigned)(q0 & 255) | ((unsigned)(q1 & 255) << 8) | ((unsigned)(q2 & 255) << 16) | ((unsigned)q3 << 24)); }
    return m * (1.f / 127.f);
}
__device__ __forceinline__ void p0_prologue(Frame& F, const Ptrs& P) {
#pragma unroll 1
    for (int sid = F.vcu; sid < 512; sid += F.G) cv8_dense(F, P, sid);
#pragma unroll 1
    for (int t = (F.vcu * NWAVES + F.wave) * 4; t < N_TOK; t += F.G * NWAVES * 4) {
        int ln = F.lane; asm volatile("" : "+v"(ln));
        f32x4 v[4][8];
#pragma unroll
        for (int q = 0; q < 4; ++q)
#pragma unroll
            for (int j = 0; j < 8; ++j) v[q][j] = ldg<f32x4>(P.x + (size_t)(t + q) * DM, (unsigned)(64 * j + ln) * 16u);
#pragma unroll
        for (int q = 0; q < 4; ++q) { const float sc = quant_row_store(P.XA8 + (size_t)(t + q) * DM, v[q], ln);
            if (ln == 0) P.asc_x[t + q] = sc; }
    }
}
__device__ __forceinline__ void load_wT(Frame& F, const float* W) {
    LAS float* wT = (LAS float*)F.lds;
    for (int i = F.tid; i < 2048 * 16; i += NWAVES * 64) wT[(i & 15) * 2048 + (i >> 4)] = W[i];
}
__device__ __forceinline__ void ln2rows(f32x4 (&v0)[8], f32x4 (&v1)[8], const LAS f32x4* gb  ) {
    float s0 = 0.f, s1 = 0.f;
#pragma unroll
    for (int j = 0; j < 8; ++j) { s0 += (v0[j].x + v0[j].y) + (v0[j].z + v0[j].w); s1 += (v1[j].x + v1[j].y) + (v1[j].z + v1[j].w); }
    const float m0 = wave_sum(s0) * (1.f / DM), m1 = wave_sum(s1) * (1.f / DM);
    float q0 = 0.f, q1 = 0.f;
#pragma unroll
    for (int j = 0; j < 8; ++j) { v0[j] = v0[j] - m0; v1[j] = v1[j] - m1;
        q0 += (v0[j].x * v0[j].x + v0[j].y * v0[j].y) + (v0[j].z * v0[j].z + v0[j].w * v0[j].w);
        q1 += (v1[j].x * v1[j].x + v1[j].y * v1[j].y) + (v1[j].z * v1[j].z + v1[j].w * v1[j].w); }
    const float r0 = 1.f / sqrtf(wave_sum(q0) * (1.f / DM) + LN_EPS), r1 = 1.f / sqrtf(wave_sum(q1) * (1.f / DM) + LN_EPS);
#pragma unroll
    for (int j = 0; j < 8; ++j) { const f32x4 g = gb[64 * j], b = gb[512 + 64 * j]; v0[j] = v0[j] * r0 * g + b; v1[j] = v1[j] * r1 * g + b; }
}
__device__ __forceinline__ void load_gb(Frame& F, const float* gain, const float* bias) {
    LAS f32x4* d = (LAS f32x4*)(F.lds + GB_OFF);
    d[F.tid] = ldg<f32x4>(gain, (unsigned)F.tid * 16u); d[512 + F.tid] = ldg<f32x4>(bias, (unsigned)F.tid * 16u);
}
typedef float v2f __attribute__((ext_vector_type(2)));
__device__ __forceinline__ int dot_lane(int r, int e) { return 2 * (16 * r + e); }
__device__ __forceinline__ float dot16x2(Frame& F, const f32x4 (&y0)[8], const f32x4 (&y1)[8]) {
    const LAS f32x4* wp = (const LAS f32x4*)F.lds + F.lane;
    const int lane = F.lane;
    float a[32];
    f32x4 wa[8], wb[8];
#define DOT_LD(W, E) _Pragma("unroll") for (int j = 0; j < 8; ++j) W[j] = wp[(E) * 512 + 64 * j];
#define DOT_MAC(W, E) { v2f c0 = {0.f, 0.f}, c1 = {0.f, 0.f};                                                                                                   \
        _Pragma("unroll") for (int j = 0; j < 8; ++j) { const v2f wl = {W[j].x, W[j].y}, wh = {W[j].z, W[j].w};                                                   \
            c0 = __builtin_elementwise_fma((v2f){y0[j].x, y0[j].y}, wl, c0); c0 = __builtin_elementwise_fma((v2f){y0[j].z, y0[j].w}, wh, c0);                     \
            c1 = __builtin_elementwise_fma((v2f){y1[j].x, y1[j].y}, wl, c1); c1 = __builtin_elementwise_fma((v2f){y1[j].z, y1[j].w}, wh, c1); }                   \
        const float r0_ = c0.x + c0.y, r1_ = c1.x + c1.y; a[E] = r0_; a[16 + (E)] = r1_; asm volatile("" : "+v"(wp) : "v"(r0_), "v"(r1_)); }
    DOT_LD(wa, 0)
#pragma unroll
    for (int e = 0; e < 16; e += 2) {
        DOT_LD(wb, e + 1)
        DOT_MAC(wa, e)
        if (e + 2 < 16) { DOT_LD(wa, e + 2) }
        DOT_MAC(wb, e + 1)
    }
#undef DOT_LD
#undef DOT_MAC
#define R32_STEP(N, BIT) _Pragma("unroll") for (int k = 0; k < (N) / 2; ++k) { const bool up = (lane >> (BIT)) & 1; const float keep = up ? a[k + (N) / 2] : a[k], send = up ? a[k] : a[k + (N) / 2]; a[k] = keep + __shfl_xor(send, 1 << (BIT)); }
    R32_STEP(32, 5) R32_STEP(16, 4) R32_STEP(8, 3) R32_STEP(4, 2) R32_STEP(2, 1)
#undef R32_STEP
    return a[0] + __shfl_xor(a[0], 1);
}
__device__ __forceinline__ f32x4 unpack4(u32x2 r) { return (f32x4){__uint_as_float(r.x << 16), __uint_as_float(r.x & 0xffff0000u), __uint_as_float(r.y << 16), __uint_as_float(r.y & 0xffff0000u)}; }
__device__ __forceinline__ void store_row_bf16(bf16* dst  , const f32x4 (&v)[8], int lane) {
#pragma unroll
    for (int j = 0; j < 8; ++j) stg<unsigned long long>(dst, (unsigned)(64 * j + lane) * 8u, (unsigned long long)pk2(v[j].x, v[j].y) | ((unsigned long long)pk2(v[j].z, v[j].w) << 32));
}
__device__ __forceinline__ void store_row_f32(float* dst  , const f32x4 (&v)[8], int lane) {
#pragma unroll
    for (int j = 0; j < 8; ++j) stg<f32x4>(dst, (unsigned)(64 * j + lane) * 16u, v[j]);
}
__device__ __forceinline__ void route16(const float (&lg)[16], const float* rb, int& e0, int& e1, float& g0, float& g1) {
    float l[16]; float m = -__builtin_inff();
#pragma unroll
    for (int e = 0; e < 16; ++e) { l[e] = lg[e] + rb[e]; m = fmaxf(m, l[e]); }
    float p[16];
#pragma unroll
    for (int e = 0; e < 16; ++e) p[e] = __expf(l[e] - m);
    int bg = 0; float bs = -1.f;
#pragma unroll
    for (int g = 0; g < 4; ++g) { const float a0 = p[4 * g], a1 = p[4 * g + 1], a2 = p[4 * g + 2], a3 = p[4 * g + 3];
        const float h1 = fmaxf(a0, a1), l1 = fminf(a0, a1), h2 = fmaxf(a2, a3), l2 = fminf(a2, a3);
        const float top = fmaxf(h1, h2), sec = fmaxf(fminf(h1, h2), h1 >= h2 ? l1 : l2), sc = top + sec;
        if (sc > bs) { bs = sc; bg = g; } }
    float a[4];
#pragma unroll
    for (int i = 0; i < 4; ++i) a[i] = bg == 0 ? p[i] : bg == 1 ? p[4 + i] : bg == 2 ? p[8 + i] : p[12 + i];
    float va = a[0], vb = -1.f; int ia = 0, ib = 0;
#pragma unroll
    for (int i = 1; i < 4; ++i) { if (a[i] > va) { vb = va; ib = ia; va = a[i]; ia = i; } else if (a[i] > vb) { vb = a[i]; ib = i; } }
    const float inv = 1.f / (va + vb);
    e0 = 4 * bg + ia; e1 = 4 * bg + ib; g0 = va * inv; g1 = vb * inv;
}
__device__ __forceinline__ void ln1_route_phase(Frame& F, const Ptrs& P, int layer, const bf16* S_in, bf16* X_out) {
    load_wT(F, P.router_w);
    LAS int* hist = (LAS int*)(F.lds + TBL_OFF);
    load_gb(F, P.ln_gain + (size_t)(layer * 2 + 0) * DM, P.ln_bias + (size_t)(layer * 2 + 0) * DM);
    float rb[16];
#pragma unroll
    for (int e = 0; e < 16; ++e) rb[e] = P.router_b[e];
    for (int ch = F.vcu; ch < N_CH; ch += F.G) {
        if (F.tid < 16) hist[F.tid] = 0;
        __syncthreads();
#pragma unroll 1
        for (int qd = 0; qd < 4; ++qd) {
            const int tq = ch * CH_TOK + F.wave * 16 + 4 * qd;
            int ln = F.lane; asm volatile("" : "+v"(ln));
            u32x2 ra0[8], ra1[8], rc0[8], rc1[8];
            { const bf16* p0 = S_in + (size_t)tq * DM;
              MEMFENCE();
#pragma unroll
              for (int j = 0; j < 8; ++j) { ra0[j] = ldg<u32x2>(p0, (unsigned)(64 * j + ln) * 8u); ra1[j] = ldg<u32x2>(p0 + DM, (unsigned)(64 * j + ln) * 8u); }
#pragma unroll
              for (int j = 0; j < 8; ++j) { rc0[j] = ldg<u32x2>(p0 + 2 * DM, (unsigned)(64 * j + ln) * 8u); rc1[j] = ldg<u32x2>(p0 + 3 * DM, (unsigned)(64 * j + ln) * 8u); }
              MEMFENCE(); }
            auto pair = [&](const u32x2 (&r0)[8], const u32x2 (&r1)[8], const int t0) {
                f32x4 v0[8], v1[8];
#pragma unroll
                for (int j = 0; j < 8; ++j) { v0[j] = unpack4(r0[j]); v1[j] = unpack4(r1[j]); }
                ln2rows(v0, v1, (const LAS f32x4*)(F.lds + GB_OFF) + ln);
                store_row_bf16(X_out + (size_t)t0 * DM, v0, ln); store_row_bf16(X_out + (size_t)(t0 + 1) * DM, v1, ln);
                { const float sc0 = quant_row_store(P.XQ8 + (size_t)t0 * DM, v0, ln), sc1 = quant_row_store(P.XQ8 + (size_t)(t0 + 1) * DM, v1, ln);
                  if (ln == 0) { P.asc_1[t0] = sc0; P.asc_1[t0 + 1] = sc1; } }
                const float mine = dot16x2(F, v0, v1);
                float lg[16];
#pragma unroll
                for (int e = 0; e < 16; ++e) { const float s0 = __uint_as_float(__builtin_amdgcn_readlane(__float_as_uint(mine), dot_lane(0, e))), s1 = __uint_as_float(__builtin_amdgcn_readlane(__float_as_uint(mine), dot_lane(1, e))); lg[e] = F.lane == 1 ? s1 : s0; }
                int e0, e1; float g0, g1;
                route16(lg, rb, e0, e1, g0, g1);
                if (F.lane < 2) { const int t = t0 + F.lane; P.tok_e[2 * t] = e0; P.tok_e[2 * t + 1] = e1; P.tok_g[2 * t] = g0; P.tok_g[2 * t + 1] = g1;
                    __hip_atomic_fetch_add(&hist[e0], 1, __ATOMIC_RELAXED, __HIP_MEMORY_SCOPE_WORKGROUP); __hip_atomic_fetch_add(&hist[e1], 1, __ATOMIC_RELAXED, __HIP_MEMORY_SCOPE_WORKGROUP); }
            };
            pair(ra0, ra1, tq);
            asm volatile("" : "+v"(ln));
            pair(rc0, rc1, tq + 2);
        }
        __syncthreads();
        if (F.tid < 16) P.wgcnt[ch * 16 + F.tid] = hist[F.tid];
        __syncthreads();
    }
}
__device__ __forceinline__ void scatter_phase(Frame& F, const Ptrs& P) {
    LAS int* cnt = (LAS int*)F.lds;
    LAS int* psum = cnt + 4096;
    LAS int* tot = psum + 512; LAS int* pst = tot + 16; LAS int* bas = pst + 16;
    LAS int* elist = bas + 16; LAS int* slist = elist + 256;
    for (int ch = F.vcu; ch < N_CH; ch += F.G) {
        { int cv[8];
#pragma unroll
          for (int k = 0; k < 8; ++k) cv[k] = P.wgcnt[F.tid + k * NWAVES * 64];
#pragma unroll
          for (int k = 0; k < 8; ++k) cnt[F.tid + k * NWAVES * 64] = cv[k]; }
        __syncthreads();
        { const int p = F.tid >> 4, e = F.tid & 15; int s = 0;
#pragma unroll
          for (int c = 0; c < 8; ++c) s += cnt[(8 * p + c) * 16 + e];
          psum[p * 16 + e] = s; }
        __syncthreads();
        if (F.tid < 16) { const int e = F.tid, mp = ch >> 3; int run = 0, mb = 0;
            for (int p = 0; p < 32; ++p) { if (p == mp) mb = run; run += psum[p * 16 + e]; }
            for (int c = 8 * mp; c < ch; ++c) mb += cnt[c * 16 + e];
            tot[e] = run; bas[e] = mb; }
        __syncthreads();
        if (F.tid == 0) { int ps = 0;
            for (int e = 0; e < 16; ++e) { pst[e] = ps; const int pd = (tot[e] + 255) & ~255;
                if (ch == 0) for (int bq = ps >> 8; bq < ((ps + pd) >> 8); ++bq) P.blk[16 + bq] = e;
                ps += pd; }
            if (ch == 0) P.blk[0] = ps >> 8; }
        __syncthreads();
        if (F.tid < 256) elist[F.tid] = P.tok_e[2 * (ch * CH_TOK) + F.tid];
        __syncthreads();
        if (F.tid < 256) { const int e = elist[F.tid]; int rank = 0;
            for (int q = 0; q < F.tid; ++q) rank += (elist[q] == e) ? 1 : 0;
            const int slot = pst[e] + bas[e] + rank; slist[F.tid] = slot;
            P.slot_of[2 * (ch * CH_TOK) + F.tid] = slot; P.slot_g[slot] = P.tok_g[2 * (ch * CH_TOK) + F.tid]; P.slot_sc[slot] = P.asc_1[ch * CH_TOK + (F.tid >> 1)]; }
        __syncthreads();
#pragma unroll 1
        for (int q0 = 0; q0 < 32; q0 += 8) {
            v4u c[8][2];
#pragma unroll
            for (int i = 0; i < 8; ++i) { const int pi = F.wave * 32 + q0 + i, tok = ch * CH_TOK + (pi >> 1);
                const GAS v4u* src = (const GAS v4u*)(P.XQ8 + (size_t)tok * DM) + F.lane; c[i][0] = src[0]; c[i][1] = src[64]; }
            asm volatile("" ::: "memory");
#pragma unroll
            for (int i = 0; i < 8; ++i) { const int slot = slist[F.wave * 32 + q0 + i];
                GAS v4u* dst = (GAS v4u*)(P.XS8 + (size_t)slot * DM) + F.lane; dst[0] = c[i][0]; dst[64] = c[i][1]; }
        }
        if (ch < 16) { const int e = ch, lo = pst[e] + tot[e], hi = pst[e] + ((tot[e] + 255) & ~255); const v4u z = {0u, 0u, 0u, 0u};
            for (int s = lo + F.wave; s < hi; s += NWAVES) { GAS v4u* dst = (GAS v4u*)(P.XS8 + (size_t)s * DM) + F.lane; dst[0] = z; dst[64] = z; if (F.lane == 0) { P.slot_g[s] = 0.f; P.slot_sc[s] = 0.f; } } }
        __syncthreads();
    }
}
__device__ __forceinline__ void combine_ln2_phase(Frame& F, const Ptrs& P, int layer, const bf16* X_in, float* out_f, bf16* out_b) {
    const bool fg = layer == 0;
    if (fg) load_wT(F, P.fg_w);
    LAS float* lf = (LAS float*)(F.lds + LF_OFF);
    load_gb(F, P.ln_gain + (size_t)(layer * 2 + 1) * DM, P.ln_bias + (size_t)(layer * 2 + 1) * DM);
    float fb[16];
#pragma unroll
    for (int e = 0; e < 16; ++e) fb[e] = P.fg_b[e];
    __syncthreads();
    for (int ch = F.vcu; ch < N_CH; ch += F.G) {
        const int myslots = P.slot_of[2 * (ch * CH_TOK + F.wave * 16) + (F.lane & 31)];
#pragma unroll 1
        for (int pr = 0; pr < 8; ++pr) {
            const int r0 = F.wave * 16 + 2 * pr, t0 = ch * CH_TOK + r0;
            int ln = F.lane; asm volatile("" : "+v"(ln));
            f32x4 v0[8], v1[8];
            { const bf16* p0 = X_in + (size_t)t0 * DM; const bf16* p1 = p0 + DM;
              const int s00 = __builtin_amdgcn_readlane(myslots, 4 * pr), s01 = __builtin_amdgcn_readlane(myslots, 4 * pr + 1);
              const int s10 = __builtin_amdgcn_readlane(myslots, 4 * pr + 2), s11 = __builtin_amdgcn_readlane(myslots, 4 * pr + 3);
              const bf16* y00 = P.XS + (size_t)s00 * DM; const bf16* y01 = P.XS + (size_t)s01 * DM; const bf16* y10 = P.XS + (size_t)s10 * DM; const bf16* y11 = P.XS + (size_t)s11 * DM;
              MEMFENCE();
#pragma unroll
              for (int j = 0; j < 8; ++j) { const unsigned ix = (unsigned)(64 * j + ln);
                  const f32x4 x0 = unpack4(ldg<u32x2>(p0, ix * 8u)), x1 = unpack4(ldg<u32x2>(p1, ix * 8u)); const u32x2 a = ldg<u32x2>(y00, ix * 8u), c = ldg<u32x2>(y01, ix * 8u), d = ldg<u32x2>(y10, ix * 8u), e = ldg<u32x2>(y11, ix * 8u);
                  v0[j].x = x0.x * ALPHA + (__uint_as_float(a.x << 16) + __uint_as_float(c.x << 16)); v0[j].y = x0.y * ALPHA + (__uint_as_float(a.x & 0xffff0000u) + __uint_as_float(c.x & 0xffff0000u));
                  v0[j].z = x0.z * ALPHA + (__uint_as_float(a.y << 16) + __uint_as_float(c.y << 16)); v0[j].w = x0.w * ALPHA + (__uint_as_float(a.y & 0xffff0000u) + __uint_as_float(c.y & 0xffff0000u));
                  v1[j].x = x1.x * ALPHA + (__uint_as_float(d.x << 16) + __uint_as_float(e.x << 16)); v1[j].y = x1.y * ALPHA + (__uint_as_float(d.x & 0xffff0000u) + __uint_as_float(e.x & 0xffff0000u));
                  v1[j].z = x1.z * ALPHA + (__uint_as_float(d.y << 16) + __uint_as_float(e.y << 16)); v1[j].w = x1.w * ALPHA + (__uint_as_float(d.y & 0xffff0000u) + __uint_as_float(e.y & 0xffff0000u));
                  if (j & 1) MEMFENCE(); } }
            ln2rows(v0, v1, (const LAS f32x4*)(F.lds + GB_OFF) + ln);
            if (out_f) { store_row_f32(out_f + (size_t)t0 * DM, v0, ln); store_row_f32(out_f + (size_t)(t0 + 1) * DM, v1, ln); }
            if (out_b) { store_row_bf16(out_b + (size_t)t0 * DM, v0, ln); store_row_bf16(out_b + (size_t)(t0 + 1) * DM, v1, ln);
                const float sc0 = quant_row_store(P.XA8 + (size_t)t0 * DM, v0, ln), sc1 = quant_row_store(P.XA8 + (size_t)(t0 + 1) * DM, v1, ln);
                if (ln == 0) { P.asc_2[t0] = sc0; P.asc_2[t0 + 1] = sc1; } }
            if (fg) {
                float z = dot16x2(F, v0, v1);
                const int hh = (F.lane >> 1) & 15;
#pragma unroll
                for (int e = 0; e < 16; ++e) z += hh == e ? fb[e] : 0.f;
                const float az = fabsf(z), lsg = fminf(z, 0.f) - log1pf(__expf(-az));
                if ((F.lane & 1) == 0) lf[(r0 + (F.lane >> 5)) * 16 + hh] = lsg;
            }
        }
        if (fg) {
            __syncthreads();
            if (F.tid < 16) { float run = 0.f; for (int i = 0; i < CH_TOK; ++i) { run += lf[i * 16 + F.tid]; lf[i * 16 + F.tid] = run; } P.cht[ch * 16 + F.tid] = run; }
            __syncthreads();
            for (int i = F.tid; i < CH_TOK * 16; i += NWAVES * 64) P.floc[(size_t)ch * CH_TOK * 16 + i] = lf[i];
            __syncthreads();
        }
    }
}
__device__ __forceinline__ void f_finalize(Frame& F, const Ptrs& P) {
    LAS float* bas = (LAS float*)(F.lds + TBL_OFF);
    for (int ch = F.vcu; ch < N_CH; ch += F.G) {
        const int b = ch >> 7, ci = ch & 127;
        { LAS float* part = bas + 16;
          const int h = F.tid & 15, p4 = F.tid >> 4; float s = 0.f;
#pragma unroll
          for (int k = 0; k < 4; ++k) { const int c = 4 * p4 + k; s += c < ci ? P.cht[(b * 128 + c) * 16 + h] : 0.f; }
          part[p4 * 16 + h] = s; }
        __syncthreads();
        if (F.tid < 16) { LAS float* part = bas + 16; float s = 0.f;
#pragma unroll
            for (int p = 0; p < 32; ++p) s += part[p * 16 + F.tid];
            bas[F.tid] = s; }
        __syncthreads();
        { float fv[4];
#pragma unroll
          for (int k = 0; k < 4; ++k) { const int i = F.tid + k * NWAVES * 64, h = i >> 7, s = i & 127; fv[k] = P.floc[(size_t)ch * CH_TOK * 16 + s * 16 + h]; }
#pragma unroll
          for (int k = 0; k < 4; ++k) { const int i = F.tid + k * NWAVES * 64, h = i >> 7, s = i & 127; P.ff[(size_t)(b * 16 + h) * SEQ + ci * CH_TOK + s] = bas[h] + fv[k]; } }
        __syncthreads();
    }
}
__device__ __forceinline__ int ord_f32(float f) { const int b = __float_as_int(f); return b >= 0 ? b : b ^ 0x7fffffff; }
__device__ __forceinline__ void qk_norms(Frame& F, const bf16* Q, const bf16* K, gu32* nrm  , float* dmin  ) {
    LAS unsigned* lm = (LAS unsigned*)(F.lds + TBL_OFF);
    LAS int* ld = (LAS int*)(lm + 32);
    for (int ch = F.vcu; ch < N_CH; ch += F.G) {
        if (F.tid < 32) lm[F.tid] = 0u;
        if (F.tid < 16) ld[F.tid] = 0x7fffffff;
        __syncthreads();
        float mq = 0.f, mk = 0.f, md = __builtin_inff();
#pragma unroll 1
        for (int r = F.wave; r < CH_TOK; r += 4 * NWAVES) {
            int ln = F.lane; asm volatile("" : "+v"(ln));
            v4u a[4][4], c[4][4];
#pragma unroll
            for (int k = 0; k < 4; ++k) { const size_t tok = (size_t)ch * CH_TOK + r + NWAVES * k;
#pragma unroll
                for (int i = 0; i < 4; ++i) { a[k][i] = ldg<v4u>(Q + tok * DM, (unsigned)ln * 64u + i * 16u); c[k][i] = ldg<v4u>(K + tok * DM, (unsigned)ln * 64u + i * 16u); } }
#pragma unroll
            for (int k = 0; k < 4; ++k) { float sq = 0.f, sk = 0.f, dq = 0.f;
#pragma unroll
                for (int i = 0; i < 4; ++i)
#pragma unroll
                    for (int w = 0; w < 4; ++w) { const float a0 = __uint_as_float(a[k][i][w] << 16), a1 = __uint_as_float(a[k][i][w] & 0xffff0000u), c0 = __uint_as_float(c[k][i][w] << 16), c1 = __uint_as_float(c[k][i][w] & 0xffff0000u);
                        sq += a0 * a0 + a1 * a1; sk += c0 * c0 + c1 * c1; dq += a0 * c0 + a1 * c1; }
                sq += __shfl_xor(sq, 1); sq += __shfl_xor(sq, 2); sk += __shfl_xor(sk, 1); sk += __shfl_xor(sk, 2); dq += __shfl_xor(dq, 1); dq += __shfl_xor(dq, 2);
                mq = fmaxf(mq, sq); mk = fmaxf(mk, sk); md = fminf(md, dq); }
        }
        if ((F.lane & 3) == 0) { __hip_atomic_fetch_max(&lm[F.lane >> 2], __float_as_uint(mq), __ATOMIC_RELAXED, __HIP_MEMORY_SCOPE_WORKGROUP);
                                 __hip_atomic_fetch_max(&lm[16 + (F.lane >> 2)], __float_as_uint(mk), __ATOMIC_RELAXED, __HIP_MEMORY_SCOPE_WORKGROUP);
                                 __hip_atomic_fetch_min(&ld[F.lane >> 2], ord_f32(md), __ATOMIC_RELAXED, __HIP_MEMORY_SCOPE_WORKGROUP); }
        __syncthreads();
        if (F.tid < 32) { const int b = ch >> 7; __hip_atomic_fetch_max(nrm + (F.tid >> 4) * 32 + b * 16 + (F.tid & 15), lm[F.tid], __ATOMIC_RELAXED, __HIP_MEMORY_SCOPE_AGENT); }
        if (F.tid < 16) { const int m = ld[F.tid]; dmin[ch * 16 + F.tid] = __int_as_float(m >= 0 ? m : m ^ 0x7fffffff); }
        __syncthreads();
    }
}
__device__ __forceinline__ void ao_quant_phase(Frame& F, const Ptrs& P) {
#pragma unroll 1
    for (int r = (F.vcu * NWAVES + F.wave) * 4; r < N_TOK; r += F.G * NWAVES * 4) {
        int ln = F.lane; asm volatile("" : "+v"(ln));
        u32x2 raw[4][8];
#pragma unroll
        for (int q = 0; q < 4; ++q)
#pragma unroll
            for (int j = 0; j < 8; ++j) raw[q][j] = ldg<u32x2>(P.AO + (size_t)(r + q) * DM, (unsigned)(64 * j + ln) * 8u);
#pragma unroll
        for (int q = 0; q < 4; ++q) { f32x4 v[8];
#pragma unroll
            for (int j = 0; j < 8; ++j) v[j] = unpack4(raw[q][j]);
            const float sc = quant_row_store(P.AO8 + (size_t)(r + q) * DM, v, ln);
            if (ln == 0) P.asc_ao[r + q] = sc; }
    }
}
__device__ __forceinline__ void hid_quant_phase(Frame& F, const Ptrs& P) {
    const int nrows = __builtin_amdgcn_readfirstlane(P.blk[0]) * 256;
#pragma unroll 1
    for (int r = (F.vcu * NWAVES + F.wave) * 4; r < nrows && r < MAX_SLOT; r += F.G * NWAVES * 4) {
        int ln = F.lane; asm volatile("" : "+v"(ln));
        u32x2 raw[4][8];
#pragma unroll
        for (int q = 0; q < 4; ++q)
#pragma unroll
            for (int j = 0; j < 8; ++j) raw[q][j] = ldg<u32x2>(P.SH + (size_t)(r + q) * DM, (unsigned)(64 * j + ln) * 8u);
#pragma unroll
        for (int q = 0; q < 4; ++q) { f32x4 v[8];
#pragma unroll
            for (int j = 0; j < 8; ++j) v[j] = unpack4(raw[q][j]);
            const float sc = quant_row_store(P.HID8 + (size_t)(r + q) * DM, v, ln);
            if (ln == 0) P.hsc[r + q] = sc * P.slot_g[r + q]; }
    }
}
__device__ __forceinline__ int load_blk_table(Frame& F, const Ptrs& P) {
    LAS int* tb = (LAS int*)(F.lds + TBL_OFF);
    if (F.tid < 16 + MAX_BLK) tb[F.tid] = P.blk[F.tid];
    __syncthreads();
    int nblk = __builtin_amdgcn_readfirstlane(tb[0]);
    return nblk > MAX_BLK ? MAX_BLK : nblk;
}

struct Args { const float* in[16]; float* out; unsigned char* ws; int ph_lo, ph_hi, li, pad; };
__device__ __forceinline__ void refresh(Frame& F) {
    int l; asm volatile("v_mbcnt_lo_u32_b32 %0, -1, 0\n\tv_mbcnt_hi_u32_b32 %0, -1, %0" : "=v"(l));
    F.lane = l; F.tid = F.wave * 64 + l;
}
__device__ __forceinline__ Ptrs mk_ptrs() {
    typedef __attribute__((address_space(4))) const Args* KA;
    KA ap = (KA)__builtin_amdgcn_kernarg_segment_ptr();
    asm volatile("" : "+s"(ap));
    Ptrs P; unsigned char* ws = ap->ws;
    P.x = ap->in[0]; P.w_qkv = ap->in[1]; P.rel_bias = ap->in[2]; P.w_ao = ap->in[3]; P.w_kv = ap->in[4]; P.fg_w = ap->in[5]; P.fg_b = ap->in[6]; P.w_bq = ap->in[7];
    P.w_bo = ap->in[8]; P.router_w = ap->in[9]; P.router_b = ap->in[10]; P.w_gate = ap->in[11]; P.w_up = ap->in[12]; P.w_down = ap->in[13]; P.ln_gain = ap->in[14]; P.ln_bias = ap->in[15];
    P.out = ap->out;
    P.Wao8 = ws + WS_WAO; P.Wbo8 = ws + WS_WBO; P.AO8 = ws + WS_XQ8; P.hmax = (float*)(ws + WS_HMAX);
    P.Wqkv8 = ws + WS_WQKV8; P.Wkvq8 = ws + WS_WKVQ8; P.Wgu8 = ws + WS_WGU8; P.Wd8 = ws + WS_WD8; P.XA8 = ws + WS_XA8; P.XQ8 = ws + WS_XQ8; P.XS8 = ws + WS_R5; P.HID8 = ws + WS_R5;
    P.SH = (bf16*)(ws + WS_R1); P.XB = (bf16*)(ws + WS_R2); P.XA = (bf16*)(ws + WS_R3); P.QKV = (bf16*)(ws + WS_R4); P.XS = (bf16*)(ws + WS_R4); P.AO = (bf16*)(ws + WS_R5);
    { unsigned char* sm = ws + WS_SMALL; P.tok_e = (int*)(sm + SM_TOKE); P.tok_g = (float*)(sm + SM_TOKG); P.slot_of = (int*)(sm + SM_SLOTOF); P.slot_g = (float*)(sm + SM_SLOTG);
      P.asc_x = (float*)(sm + SM_ASCX); P.asc_1 = (float*)(sm + SM_ASC1); P.asc_2 = (float*)(sm + SM_ASC2); P.slot_sc = (float*)(sm + SM_SLOTSC);
      P.wsc_qkv = (float*)(sm + SM_WSCQKV); P.wsc_kvq = (float*)(sm + SM_WSCKVQ); P.wsc_gu = (float*)(sm + SM_WSCGU); P.wsc_d = (float*)(sm + SM_WSCD); P.hsc = (float*)(sm + SM_HSC); P.wsc_ao = (float*)(sm + SM_WSCAO); P.wsc_bo = (float*)(sm + SM_WSCBO); P.asc_ao = (float*)(sm + SM_ASCAO);
      P.wgcnt = (int*)(sm + SM_WGCNT); P.blk = (int*)(sm + SM_BLK); P.cht = (float*)(sm + SM_CHT); P.dmin = (float*)(sm + SM_DMIN); P.floc = (float*)(sm + SM_FLOC); P.ff = (float*)(sm + SM_FF); }
    return P;
}
__global__ void __launch_bounds__(NWAVES * 64, 2) yoco_fwd(Args args) {
    extern __shared__ __attribute__((aligned(16))) unsigned char lds[];
    Frame F;
    F.lds = (LAS unsigned char*)lds;
    F.MISC = (volatile LAS unsigned*)(F.lds + MISC_OFF);
    F.tid = threadIdx.x; F.lane = F.tid & 63; F.wave = __builtin_amdgcn_readfirstlane(F.tid >> 6);
    F.G = gridDim.x; { const int bx = blockIdx.x; F.vcu = (F.G % 8 == 0) ? (bx % 8) * (F.G / 8) + bx / 8 : bx; }
    for (int u = F.tid; u < 64; u += NWAVES * 64) ((LAS unsigned*)(F.lds + MISC_OFF))[u] = 0u;
    __syncthreads();
    unsigned* const barw = (unsigned*)(args.ws + WS_CTL) + CW_BAR;
    XcdBarrier bar; bar.bar = barw; bar.x = 0; bar.st = nullptr;
    if (N_LAUNCHES == 1) bar = xcd_barrier_post(barw, F.MISC + 8, F.tid == 0);
#define GRID_BAR() do { if (N_LAUNCHES == 1) xcd_barrier(bar, F.tid == 0); } while (0)
    const int lo = args.ph_lo, hi = args.ph_hi;
#ifndef PH_MASK
#define PH_MASK 0x3fffff
#endif
#define IN(k) ((((PH_MASK) >> (k)) & 1) && lo <= (k) && (k) < hi)
#define BOTH(k) (IN(k) && IN((k) + 1))
    constexpr size_t TSTRIDE = (size_t)N_TOK * DM;
    LAS unsigned char* ring = F.lds;

    if (IN(0)) { asm volatile("; PHASE_0" ::: "memory"); refresh(F); const Ptrs P = mk_ptrs(); p0_prologue(F, P); if (BOTH(0)) GRID_BAR(); }

    if (IN(1)) { asm volatile("; PHASE_1" ::: "memory"); refresh(F); const Ptrs P = mk_ptrs();
        pg8::Gemm g{(const bf16*)P.XA8, (const bf16*)P.Wqkv8, N_TOK, 3 * DM, DM / 2}; pg8::StaticOrder S; S.init(N_TOK, 3 * DM, F.G, (int)blockIdx.x);
        pg8::EpiBf16Q E{P.QKV, DM, DM, TSTRIDE, P.asc_x, P.wsc_qkv};
        pg8::gemm_phase<pg8::EpiBf16Q, pg8::StaticOrder, true, true>(ring, g, S, E, F.tid);
        if (BOTH(1)) GRID_BAR();
    }
    if (IN(2)) { asm volatile("; PHASE_2" ::: "memory"); refresh(F); const Ptrs P = mk_ptrs();
        cv_side(F, P, 0);
        refresh(F);
        const int xq = (F.G % 8 == 0) ? (int)(blockIdx.x % 8) : 0, nq = (F.G % 8 == 0) ? 8 : 1, perq = 4096 / nq, perg = F.G / nq;
        gu32* qh = (gu32*)(args.ws + WS_CTL) + CW_QHEAD2 + 64 * xq;
        volatile LAS int* qslot = (volatile LAS int*)(F.lds + TBL_OFF + 256);
        if (F.tid == 0) qslot[0] = (int)__hip_atomic_fetch_add(qh, 1u, __ATOMIC_RELAXED, __HIP_MEMORY_SCOPE_AGENT);
        __syncthreads();
        for (;;) {
            const int n = __builtin_amdgcn_readfirstlane(qslot[0]) % (perq + perg); if (n >= perq) break;
            const int L = ((n >> 5) * nq + xq) * 32 + (n & 31), c2 = L & 127, hp = (L >> 7) & 15, b = L >> 11;
            att::Blk k; k.P0 = c2 * 128; k.j_lo = 0; k.F = nullptr; k.tab = P.rel_bias + (size_t)(hp * 2) * 257;
            k.Q = P.QKV + ((size_t)b * SEQ + k.P0) * DM + hp * 128; k.O = P.AO + ((size_t)b * SEQ + k.P0) * DM + hp * 128;
            k.K = P.QKV + TSTRIDE + (size_t)b * SEQ * DM + hp * 128; k.V = P.QKV + 2 * TSTRIDE + (size_t)b * SEQ * DM + hp * 128;
            unsigned nxt = 0u; if (F.tid == 0) nxt = __hip_atomic_fetch_add(qh, 1u, __ATOMIC_RELAXED, __HIP_MEMORY_SCOPE_AGENT);
            att::attn_block<1>(k, (char*)lds, F.tid);
            if (F.tid == 0) qslot[0] = (int)nxt;
            __syncthreads();
        }
        if (BOTH(2)) GRID_BAR();
    }
    if (IN(3)) { asm volatile("; PHASE_3" ::: "memory"); refresh(F); const Ptrs P = mk_ptrs(); ao_quant_phase(F, P); if (BOTH(3)) GRID_BAR(); }
    if (IN(4)) { asm volatile("; PHASE_4" ::: "memory"); refresh(F); const Ptrs P = mk_ptrs();
        pg8::Gemm g{(const bf16*)P.AO8, (const bf16*)P.Wao8, N_TOK, DM, DM / 2}; pg8::StaticOrder S; S.init(N_TOK, DM, F.G, (int)blockIdx.x);
        pg8::EpiResQ<true> E{P.x, P.SH, ALPHA, P.asc_ao, P.wsc_ao};
        pg8::gemm_phase<pg8::EpiResQ<true>, pg8::StaticOrder, true, true>(ring, g, S, E, F.tid);
        if (BOTH(4)) GRID_BAR();
    }
    if (IN(5)) { asm volatile("; PHASE_5" ::: "memory"); refresh(F); const Ptrs P = mk_ptrs(); ln1_route_phase(F, P, 0, P.SH, P.XB); if (BOTH(5)) GRID_BAR(); }
    if (IN(6)) { asm volatile("; PHASE_6" ::: "memory"); refresh(F); const Ptrs P = mk_ptrs(); scatter_phase(F, P); if (BOTH(6)) GRID_BAR(); }
    if (IN(7)) { asm volatile("; PHASE_7" ::: "memory"); refresh(F); const Ptrs P = mk_ptrs();
        const int nblk = load_blk_table(F, P);
        pg8::Gemm g{(const bf16*)P.XS8, (const bf16*)P.Wgu8, MAX_SLOT, 4096, DM / 2}; pg8::MoeOrder S; S.init(nblk, 4096, F.G, (int)blockIdx.x, (const LAS int*)(F.lds + TBL_OFF) + 16, (size_t)4096 * 2048);
        pg8::EpiSwiGLUQ E{P.SH, P.slot_sc, P.wsc_gu};
        pg8::gemm_phase<pg8::EpiSwiGLUQ, pg8::MoeOrder, true, true>(ring, g, S, E, F.tid);
        if (BOTH(7)) GRID_BAR();
    }
    if (IN(8)) { asm volatile("; PHASE_8" ::: "memory"); refresh(F); const Ptrs P = mk_ptrs(); hid_quant_phase(F, P); if (BOTH(8)) GRID_BAR(); }
    if (IN(9)) { asm volatile("; PHASE_9" ::: "memory"); refresh(F); const Ptrs P = mk_ptrs();
        const int nblk = load_blk_table(F, P);
        pg8::Gemm g{(const bf16*)P.HID8, (const bf16*)P.Wd8, MAX_SLOT, DM, DM / 2}; pg8::MoeOrder S; S.init(nblk, DM, F.G, (int)blockIdx.x, (const LAS int*)(F.lds + TBL_OFF) + 16, (size_t)2048 * 2048);
        pg8::EpiGateQ E{P.XS, P.hsc, P.wsc_d};
        pg8::gemm_phase<pg8::EpiGateQ, pg8::MoeOrder, true, true>(ring, g, S, E, F.tid);
        if (BOTH(9)) GRID_BAR();
    }
    if (IN(10)) { asm volatile("; PHASE_10" ::: "memory"); refresh(F); const Ptrs P = mk_ptrs(); combine_ln2_phase(F, P, 0, P.XB, nullptr, P.XA); if (BOTH(10)) GRID_BAR(); }
    if (IN(11)) { asm volatile("; PHASE_11" ::: "memory"); refresh(F); const Ptrs P = mk_ptrs();
        f_finalize(F, P);
        pg8::Gemm g{(const bf16*)P.XA8, (const bf16*)P.Wkvq8, N_TOK, 3 * DM, DM / 2}; pg8::StaticOrder S; S.init(N_TOK, 3 * DM, F.G, (int)blockIdx.x);
        pg8::EpiBf16Q E{P.QKV, DM, DM, TSTRIDE, P.asc_2, P.wsc_kvq};
        pg8::gemm_phase<pg8::EpiBf16Q, pg8::StaticOrder, true, true>(ring, g, S, E, F.tid);
        if (BOTH(11)) GRID_BAR();
    }
    if (IN(12)) { asm volatile("; PHASE_12" ::: "memory"); refresh(F); const Ptrs P = mk_ptrs();
        qk_norms(F, P.QKV + 2 * TSTRIDE, P.QKV, (gu32*)(args.ws + WS_CTL) + CW_NORM, P.dmin);
        if (BOTH(12)) GRID_BAR();
    }
    if (IN(13)) { asm volatile("; PHASE_13" ::: "memory"); refresh(F); const Ptrs P = mk_ptrs();
        cv_side(F, P, 1);
        refresh(F);
        gu32* nrm = (gu32*)(args.ws + WS_CTL) + CW_NORM; gu32* qhead = (gu32*)(args.ws + WS_CTL) + CW_QHEAD;
        volatile LAS int* qslot = (volatile LAS int*)(F.lds + TBL_OFF + 256);
        constexpr int NBLK10 = NB * 16 * 64;
        if (F.tid == 0) qslot[0] = (int)__hip_atomic_fetch_add(qhead, 1u, __ATOMIC_RELAXED, __HIP_MEMORY_SCOPE_AGENT);
        __syncthreads();
        for (;;) {
            const int n = __builtin_amdgcn_readfirstlane(qslot[0]) % (NBLK10 + F.G); if (n >= NBLK10) break;
            const int qb = 63 - (n >> 5), bh = n & 31, b = bh >> 4, h = bh & 15;
            att::Blk k; k.P0 = qb * 256; k.tab = nullptr; k.F = P.ff + (size_t)bh * SEQ;
            { const float q2 = __uint_as_float(__hip_atomic_load(nrm + bh, __ATOMIC_RELAXED, __HIP_MEMORY_SCOPE_AGENT)), k2 = __uint_as_float(__hip_atomic_load(nrm + 32 + bh, __ATOMIC_RELAXED, __HIP_MEMORY_SCOPE_AGENT));
              const int chq = b * 128 + 2 * qb;
              const float dmn = fminf(__uint_as_float(__builtin_amdgcn_readfirstlane(__float_as_uint(P.dmin[chq * 16 + h]))), __uint_as_float(__builtin_amdgcn_readfirstlane(__float_as_uint(P.dmin[(chq + 1) * 16 + h]))));
              const float thr = -(48.02f + 0.08838834764831845f * (1.001f * sqrtf(q2) * sqrtf(k2) - dmn));
              int ln = F.lane; asm volatile("" : "+v"(ln));
              const float f0 = ldg<float>(k.F + k.P0, 0u); const int C0 = k.P0 >> 6; int cnt = 0;
#pragma unroll
              for (int i = 0; i < 4; ++i) { const int j = ln + 64 * i; const bool in = j < C0; const float fj = ldg<float>(k.F, in ? (unsigned)(64 * j + 63) * 4u : 0u);
                  cnt += __builtin_popcountll(__ballot(in && (f0 - fj < thr))); }
              k.j_lo = __builtin_amdgcn_readfirstlane(cnt); }
            bf16* q = P.QKV + 2 * TSTRIDE + ((size_t)b * SEQ + k.P0) * DM + h * 128;
            k.Q = q; k.O = P.AO + ((size_t)b * SEQ + k.P0) * DM + h * 128; k.K = P.QKV + (size_t)b * SEQ * DM + h * 128; k.V = P.QKV + TSTRIDE + (size_t)b * SEQ * DM + h * 128;
            att::attn_block<0>(k, (char*)lds, F.tid);
            if (F.tid == 0) qslot[0] = (int)__hip_atomic_fetch_add(qhead, 1u, __ATOMIC_RELAXED, __HIP_MEMORY_SCOPE_AGENT);
            __syncthreads();
        }
        if (BOTH(13)) GRID_BAR();
    }
    if (IN(14)) { asm volatile("; PHASE_14" ::: "memory"); refresh(F); const Ptrs P = mk_ptrs(); ao_quant_phase(F, P); if (BOTH(14)) GRID_BAR(); }
    if (IN(15)) { asm volatile("; PHASE_15" ::: "memory"); refresh(F); const Ptrs P = mk_ptrs();
        pg8::Gemm g{(const bf16*)P.AO8, (const bf16*)P.Wbo8, N_TOK, DM, DM / 2}; pg8::StaticOrder S; S.init(N_TOK, DM, F.G, (int)blockIdx.x);
        pg8::EpiResQ<false> E{P.XA, P.SH, ALPHA, P.asc_ao, P.wsc_bo};
        pg8::gemm_phase<pg8::EpiResQ<false>, pg8::StaticOrder, true, true>(ring, g, S, E, F.tid);
        if (BOTH(15)) GRID_BAR();
    }
    if (IN(16)) { asm volatile("; PHASE_16" ::: "memory"); refresh(F); const Ptrs P = mk_ptrs(); ln1_route_phase(F, P, 1, P.SH, P.XB); if (BOTH(16)) GRID_BAR(); }
    if (IN(17)) { asm volatile("; PHASE_17" ::: "memory"); refresh(F); const Ptrs P = mk_ptrs(); scatter_phase(F, P); if (BOTH(17)) GRID_BAR(); }
    if (IN(18)) { asm volatile("; PHASE_18" ::: "memory"); refresh(F); const Ptrs P = mk_ptrs();
        const int nblk = load_blk_table(F, P);
        pg8::Gemm g{(const bf16*)(P.XS8), (const bf16*)(P.Wgu8 + (size_t)16 * 4096 * 2048), MAX_SLOT, 4096, DM / 2}; pg8::MoeOrder S; S.init(nblk, 4096, F.G, (int)blockIdx.x, (const LAS int*)(F.lds + TBL_OFF) + 16, (size_t)4096 * 2048);
        pg8::EpiSwiGLUQ E{P.SH, P.slot_sc, P.wsc_gu + (size_t)16 * 4096};
        pg8::gemm_phase<pg8::EpiSwiGLUQ, pg8::MoeOrder, true, true>(ring, g, S, E, F.tid);
        if (BOTH(18)) GRID_BAR();
    }
    if (IN(19)) { asm volatile("; PHASE_19" ::: "memory"); refresh(F); const Ptrs P = mk_ptrs(); hid_quant_phase(F, P); if (BOTH(19)) GRID_BAR(); }
    if (IN(20)) { asm volatile("; PHASE_20" ::: "memory"); refresh(F); const Ptrs P = mk_ptrs();
        const int nblk = load_blk_table(F, P);
        pg8::Gemm g{(const bf16*)P.HID8, (const bf16*)(P.Wd8 + (size_t)16 * 2048 * 2048), MAX_SLOT, DM, DM / 2}; pg8::MoeOrder S; S.init(nblk, DM, F.G, (int)blockIdx.x, (const LAS int*)(F.lds + TBL_OFF) + 16, (size_t)2048 * 2048);
        pg8::EpiGateQ E{P.XS, P.hsc, P.wsc_d + (size_t)16 * 2048};
        pg8::gemm_phase<pg8::EpiGateQ, pg8::MoeOrder, true, true>(ring, g, S, E, F.tid);
        if (BOTH(20)) GRID_BAR();
    }
    if (IN(21)) { asm volatile("; PHASE_21" ::: "memory"); refresh(F); const Ptrs P = mk_ptrs(); combine_ln2_phase(F, P, 1, P.XB, P.out, nullptr); }
#undef IN
#undef BOTH
#undef GRID_BAR
}

extern "C" void kernel_launch(void* const* d_in, const int* in_sizes, int n_in, void* d_out, int out_size, void* d_ws, size_t ws_size, hipStream_t stream) {
    static int grid = 0;
    if (grid == 0) {
        if (n_in != 16 || in_sizes[0] != N_TOK * DM || out_size != N_TOK * DM || ws_size < WS_END) { fprintf(stderr, "kernel_launch: shape mismatch (n_in %d, in0 %d, out %d, ws %zu < %zu); nothing launched\n", n_in, n_in > 0 ? in_sizes[0] : -1, out_size, ws_size, (size_t)WS_END); grid = -1; return; }
        int dev = 0, cus = 0, per_cu = 0;
        if (hipGetDevice(&dev) != hipSuccess || hipDeviceGetAttribute(&cus, hipDeviceAttributeMultiprocessorCount, dev) != hipSuccess) { fprintf(stderr, "kernel_launch: device query failed\n"); grid = -1; return; }
        if (hipFuncSetAttribute((const void*)yoco_fwd, hipFuncAttributeMaxDynamicSharedMemorySize, LDS_BYTES) != hipSuccess) { fprintf(stderr, "kernel_launch: hipFuncSetAttribute failed\n"); grid = -1; return; }
        if (hipOccupancyMaxActiveBlocksPerMultiprocessor(&per_cu, (const void*)yoco_fwd, NWAVES * 64, LDS_BYTES) != hipSuccess || per_cu < 1)
            fprintf(stderr, "kernel_launch: note: occupancy query reports %d workgroups per CU\n", per_cu);
        (void)hipGetLastError();
        grid = cus;
    }
    if (grid < 0) return;
    if (hipMemsetAsync((char*)d_ws + WS_CTL, 0, CTL_ZERO_BYTES, stream) != hipSuccess) { fprintf(stderr, "kernel_launch: memset failed\n"); return; }
    Args a{};
    for (int i = 0; i < 16; ++i) a.in[i] = (const float*)d_in[i];
    a.out = (float*)d_out; a.ws = (unsigned char*)d_ws;
#ifndef DUP_MASK
#define DUP_MASK 0
#endif
    for (int li = 0; li < N_LAUNCHES; ++li) {
        a.ph_lo = (N_LAUNCHES == 1) ? 0 : li; a.ph_hi = (N_LAUNCHES == 1) ? N_PHASES : li + 1; a.li = li; a.pad = 0;
#ifndef PROBE_KSHIFT
#define PROBE_KSHIFT 0
#endif
        if (N_LAUNCHES != 1 && (((DUP_MASK) >> li) & 1)) { a.pad = PROBE_KSHIFT; hipLaunchKernelGGL(yoco_fwd, dim3(grid), dim3(NWAVES * 64), LDS_BYTES, stream, a); a.pad = 0; }
        hipLaunchKernelGGL(yoco_fwd, dim3(grid), dim3(NWAVES * 64), LDS_BYTES, stream, a);
        const hipError_t le = hipPeekAtLastError();
        if (le != hipSuccess) { fprintf(stderr, "kernel_launch: launch %d failed: %s\n", li, hipGetErrorName(le)); break; }
    }
}
```
